# Optimizing an MI355X kernel written in HIP

```python
import math
import jax, jax.numpy as jnp
from jax import lax
import numpy as np

D_MODEL = 1024
BATCH = 16
SEQ = 2048
DEPTH = 4

MEM_LEN = 256
EPS = 1e-6
SSM_WIDTH = 384
SSM_GROUP = 16
SSM_GROUPS = SSM_WIDTH // SSM_GROUP
SSM_STATE = 64
DIFF_HEADS = 4
DIFF_HD = 64
DIFF_QK = DIFF_HEADS * 2 * DIFF_HD
DIFF_V = DIFF_HEADS * 2 * DIFF_HD
Q_BLOCK = 128
ROPE_THETA = 10000.0
LRU_WIDTH = 512
LRU_HEADS = 8
LRU_HD = LRU_WIDTH // LRU_HEADS
LRU_CONV = 4
LRU_C = 8.0
N_BRANCH = 3
IN_WIDTHS = (SSM_WIDTH, DIFF_QK, DIFF_QK, DIFF_V, LRU_WIDTH, LRU_WIDTH, N_BRANCH * D_MODEL)
D_IN = SSM_WIDTH + 2 * DIFF_QK + DIFF_V + 2 * LRU_WIDTH + N_BRANCH * D_MODEL
XATTN_HEADS = 4
XATTN_HD = D_MODEL // XATTN_HEADS
D_FF = 2816
FFN_CONV = 3

kernel_name = "hybrid_s5_diffattn_rglru_convffn"


def rmsnorm(x, g):
    x32 = x.astype(jnp.float32)
    y = x32 * lax.rsqrt(jnp.mean(x32 * x32, axis=-1, keepdims=True) + EPS)
    return (y * g.astype(jnp.float32)).astype(x.dtype)


def causal_dwconv(x, w, b):
    k_w = w.shape[0]
    L = x.shape[1]
    xp = jnp.pad(x, ((0, 0), (k_w - 1, 0), (0, 0)))
    y = xp[:, 0:L] * w[0]
    for j in range(1, k_w):
        y = y + xp[:, j:j + L] * w[j]
    return y + b


def rope_tables(positions):
    inv = jnp.exp(-math.log(ROPE_THETA) * jnp.arange(0, DIFF_HD, 2, dtype=jnp.float32) / DIFF_HD)
    ang = positions.astype(jnp.float32)[..., None] * inv
    return jnp.cos(ang)[:, :, None, None, :], jnp.sin(ang)[:, :, None, None, :]


def apply_rope(x, cos, sin):
    half = x.shape[-1] // 2
    x1, x2 = x[..., :half], x[..., half:]
    c = cos.astype(x.dtype)
    s = sin.astype(x.dtype)
    return jnp.concatenate([x1 * c - x2 * s, x2 * c + x1 * s], axis=-1)


def _complex_combine(e1, e2):
    a1r, a1i, b1r, b1i = e1
    a2r, a2i, b2r, b2i = e2
    return (a2r * a1r - a2i * a1i,
            a2r * a1i + a2i * a1r,
            a2r * b1r - a2i * b1i + b2r,
            a2r * b1i + a2i * b1r + b2i)


def _real_combine(e1, e2):
    a1, b1 = e1
    a2, b2 = e2
    return a2 * a1, a2 * b1 + b2


def s5_branch(u, lam_re, lam_im, log_step, b_re, b_im, c_re, c_im, d_skip, w_glu, b_glu):
    f32 = jnp.float32
    Bsz, L, _ = u.shape
    u32 = u.astype(f32)
    ug = u32.reshape(Bsz, L, SSM_GROUPS, SSM_GROUP)
    lr = lam_re.astype(f32)
    li = lam_im.astype(f32)
    dt = jnp.exp(log_step.astype(f32))[:, None]
    mag = jnp.exp(lr * dt)
    ab_r = mag * jnp.cos(li * dt)
    ab_i = mag * jnp.sin(li * dt)
    den = lr * lr + li * li
    nr = ab_r - 1.0
    f_r = (nr * lr + ab_i * li) / den
    f_i = (ab_i * lr - nr * li) / den
    br = b_re.astype(f32)
    bi = b_im.astype(f32)
    bb_r = f_r[..., None] * br - f_i[..., None] * bi
    bb_i = f_r[..., None] * bi + f_i[..., None] * br
    bu_r = jnp.einsum('gph,blgh->blgp', bb_r, ug)
    bu_i = jnp.einsum('gph,blgh->blgp', bb_i, ug)
    a_r = jnp.broadcast_to(ab_r, (1, L, SSM_GROUPS, SSM_STATE))
    a_i = jnp.broadcast_to(ab_i, (1, L, SSM_GROUPS, SSM_STATE))
    _, _, s_r, s_i = lax.associative_scan(_complex_combine, (a_r, a_i, bu_r, bu_i), axis=1)
    y = (jnp.einsum('ghp,blgp->blgh', c_re.astype(f32), s_r)
         - jnp.einsum('ghp,blgp->blgh', c_im.astype(f32), s_i))
    y = y.reshape(Bsz, L, SSM_WIDTH) + d_skip.astype(f32) * u32
    y = jax.nn.gelu(y)
    z = y @ w_glu.astype(f32) + b_glu.astype(f32)
    out = z[..., :SSM_WIDTH] * jax.nn.sigmoid(z[..., SSM_WIDTH:])
    return out.astype(u.dtype)


def diff_attention_branch(q, k, v, cos, sin, lq1, lk1, lq2, lk2, subln_g, lambda_init):
    Bsz, L, _ = q.shape
    q = apply_rope(q.reshape(Bsz, L, DIFF_HEADS, 2, DIFF_HD), cos, sin)
    k = apply_rope(k.reshape(Bsz, L, DIFF_HEADS, 2, DIFF_HD), cos, sin)
    v = v.reshape(Bsz, L, DIFF_HEADS, 2 * DIFF_HD)
    f32 = jnp.float32
    lam = (jnp.exp(jnp.sum(lq1.astype(f32) * lk1.astype(f32)))
           - jnp.exp(jnp.sum(lq2.astype(f32) * lk2.astype(f32))) + lambda_init)
    scale = DIFF_HD ** -0.5
    nb = L // Q_BLOCK
    qb = q.reshape(Bsz, nb, Q_BLOCK, DIFF_HEADS, 2, DIFF_HD).transpose(1, 0, 2, 3, 4, 5)
    key_pos = jnp.arange(L)

    def block(args):
        qblk, bidx = args
        s = jnp.einsum('bqhcd,bkhcd->bhcqk', qblk, k).astype(f32) * scale
        qpos = bidx * Q_BLOCK + jnp.arange(Q_BLOCK)
        mask = key_pos[None, :] <= qpos[:, None]
        s = jnp.where(mask, s, -jnp.inf)
        p = jax.nn.softmax(s, axis=-1)
        attn = p[:, :, 0] - lam * p[:, :, 1]
        return jnp.einsum('bhqk,bkhe->bqhe', attn.astype(v.dtype), v)

    o = lax.map(block, (qb, jnp.arange(nb)))
    o = o.transpose(1, 0, 2, 3, 4).reshape(Bsz, L, DIFF_HEADS, 2 * DIFF_HD)
    o = rmsnorm(o, subln_g) * (1.0 - lambda_init)
    return o.reshape(Bsz, L, DIFF_V)


def rglru_branch(xr, gr, conv_w, conv_b, wa, ba, wx, bx, lam):
    Bsz, L, _ = xr.shape
    f32 = jnp.float32
    xc = causal_dwconv(xr, conv_w, conv_b)
    xh = xc.reshape(Bsz, L, LRU_HEADS, LRU_HD)
    r = jax.nn.sigmoid(jnp.einsum('blhi,hij->blhj', xh, wa).reshape(Bsz, L, LRU_WIDTH) + ba)
    ig = jax.nn.sigmoid(jnp.einsum('blhi,hij->blhj', xh, wx).reshape(Bsz, L, LRU_WIDTH) + bx)
    log_a = -LRU_C * r.astype(f32) * jax.nn.softplus(-lam.astype(f32))
    a = jnp.exp(log_a)
    b = jnp.sqrt(-jnp.expm1(2.0 * log_a)) * (ig * xc).astype(f32)
    _, h = lax.associative_scan(_real_combine, (a, b), axis=1)
    return h.astype(xr.dtype) * jax.nn.gelu(gr)


def cross_attention(h, m, wq, wkv, wo):
    Bsz, L, _ = h.shape
    M = m.shape[1]
    q = (h @ wq).reshape(Bsz, L, XATTN_HEADS, XATTN_HD)
    kv = m @ wkv
    k = kv[..., :D_MODEL].reshape(Bsz, M, XATTN_HEADS, XATTN_HD)
    v = kv[..., D_MODEL:].reshape(Bsz, M, XATTN_HEADS, XATTN_HD)
    s = jnp.einsum('bqhd,bkhd->bhqk', q, k).astype(jnp.float32) * (XATTN_HD ** -0.5)
    p = jax.nn.softmax(s, axis=-1)
    o = jnp.einsum('bhqk,bkhd->bqhd', p.astype(v.dtype), v).reshape(Bsz, L, D_MODEL)
    return o @ wo


def conv_ffn(h, w_up, conv_w, conv_b, w_down):
    up = causal_dwconv(h @ w_up, conv_w, conv_b)
    val = up[..., :D_FF]
    gate = up[..., D_FF:]
    return (jax.nn.silu(gate) * val) @ w_down


def setup_inputs(seed: int = 0) -> dict:
    key = jax.random.key(seed)
    ks = iter(jax.random.split(key, 64))
    f32 = jnp.float32

    def nrm(shape, scale):
        return scale * jax.random.normal(next(ks), shape, f32)

    x = nrm((BATCH, SEQ, D_MODEL), 1.0)
    mem = nrm((BATCH, MEM_LEN, D_MODEL), 1.0)
    offs = jax.random.randint(next(ks), (BATCH, 1), 0, 4096, dtype=jnp.int32)
    positions = (offs + jnp.arange(SEQ, dtype=jnp.int32)[None, :]).astype(jnp.int32)
    norm_mix_g = 1.0 + nrm((DEPTH, D_MODEL), 0.05)
    w_in = nrm((DEPTH, D_MODEL, D_IN), D_MODEL ** -0.5)
    ssm_lambda_re = -0.5 + nrm((DEPTH, SSM_GROUPS, SSM_STATE), 0.01)
    ssm_lambda_im = math.pi * jnp.arange(SSM_STATE, dtype=f32)[None, None, :] + nrm((DEPTH, SSM_GROUPS, SSM_STATE), 0.01)
    ssm_log_step = jax.random.uniform(next(ks), (DEPTH, SSM_GROUPS), f32, math.log(1e-3), math.log(1e-1))
    ssm_b_re = nrm((DEPTH, SSM_GROUPS, SSM_STATE, SSM_GROUP), (2 * SSM_GROUP) ** -0.5)
    ssm_b_im = nrm((DEPTH, SSM_GROUPS, SSM_STATE, SSM_GROUP), (2 * SSM_GROUP) ** -0.5)
    ssm_c_re = nrm((DEPTH, SSM_GROUPS, SSM_GROUP, SSM_STATE), SSM_STATE ** -0.5)
    ssm_c_im = nrm((DEPTH, SSM_GROUPS, SSM_GROUP, SSM_STATE), SSM_STATE ** -0.5)
    ssm_d = nrm((DEPTH, SSM_WIDTH), 1.0)
    ssm_w_glu = nrm((DEPTH, SSM_WIDTH, 2 * SSM_WIDTH), SSM_WIDTH ** -0.5)
    ssm_b_glu = nrm((DEPTH, 2 * SSM_WIDTH), 0.01)
    diff_lq1 = nrm((DEPTH, DIFF_HD), 0.1)
    diff_lk1 = nrm((DEPTH, DIFF_HD), 0.1)
    diff_lq2 = nrm((DEPTH, DIFF_HD), 0.1)
    diff_lk2 = nrm((DEPTH, DIFF_HD), 0.1)
    diff_subln_g = 1.0 + nrm((DEPTH, 2 * DIFF_HD), 0.05)
    lru_conv_w = nrm((DEPTH, LRU_CONV, LRU_WIDTH), LRU_CONV ** -0.5)
    lru_conv_b = nrm((DEPTH, LRU_WIDTH), 0.01)
    lru_wa = nrm((DEPTH, LRU_HEADS, LRU_HD, LRU_HD), LRU_HD ** -0.5)
    lru_ba = nrm((DEPTH, LRU_WIDTH), 0.01)
    lru_wx = nrm((DEPTH, LRU_HEADS, LRU_HD, LRU_HD), LRU_HD ** -0.5)
    lru_bx = nrm((DEPTH, LRU_WIDTH), 0.01)
    a0 = jax.random.uniform(next(ks), (DEPTH, LRU_WIDTH), f32, 0.9, 0.999)
    s0 = a0 ** (1.0 / LRU_C)
    lru_lambda = jnp.log(s0) - jnp.log1p(-s0)
    w_br_ssm = nrm((DEPTH, SSM_WIDTH, D_MODEL), SSM_WIDTH ** -0.5)
    w_br_attn = nrm((DEPTH, DIFF_V, D_MODEL), DIFF_V ** -0.5)
    w_br_lru = nrm((DEPTH, LRU_WIDTH, D_MODEL), LRU_WIDTH ** -0.5)
    w_out = nrm((DEPTH, D_MODEL, D_MODEL), D_MODEL ** -0.5)
    norm_xattn_g = 1.0 + nrm((DEPTH, D_MODEL), 0.05)
    norm_mem_g = 1.0 + nrm((DEPTH, D_MODEL), 0.05)
    xattn_wq = nrm((DEPTH, D_MODEL, D_MODEL), D_MODEL ** -0.5)
    xattn_wkv = nrm((DEPTH, D_MODEL, 2 * D_MODEL), D_MODEL ** -0.5)
    xattn_wo = nrm((DEPTH, D_MODEL, D_MODEL), D_MODEL ** -0.5)
    norm_ffn_g = 1.0 + nrm((DEPTH, D_MODEL), 0.05)
    ffn_w_up = nrm((DEPTH, D_MODEL, 2 * D_FF), D_MODEL ** -0.5)
    ffn_conv_w = nrm((DEPTH, FFN_CONV, 2 * D_FF), FFN_CONV ** -0.5)
    ffn_conv_b = nrm((DEPTH, 2 * D_FF), 0.01)
    ffn_w_down = nrm((DEPTH, D_FF, D_MODEL), D_FF ** -0.5)
    final_norm_g = 1.0 + nrm((D_MODEL,), 0.05)
    return {"x": x, "mem": mem, "positions": positions, "norm_mix_g": norm_mix_g, "w_in": w_in,
            "ssm_lambda_re": ssm_lambda_re, "ssm_lambda_im": ssm_lambda_im, "ssm_log_step": ssm_log_step,
            "ssm_b_re": ssm_b_re, "ssm_b_im": ssm_b_im, "ssm_c_re": ssm_c_re, "ssm_c_im": ssm_c_im,
            "ssm_d": ssm_d, "ssm_w_glu": ssm_w_glu, "ssm_b_glu": ssm_b_glu,
            "diff_lq1": diff_lq1, "diff_lk1": diff_lk1, "diff_lq2": diff_lq2, "diff_lk2": diff_lk2,
            "diff_subln_g": diff_subln_g, "lru_conv_w": lru_conv_w, "lru_conv_b": lru_conv_b,
            "lru_wa": lru_wa, "lru_ba": lru_ba, "lru_wx": lru_wx, "lru_bx": lru_bx, "lru_lambda": lru_lambda,
            "w_br_ssm": w_br_ssm, "w_br_attn": w_br_attn, "w_br_lru": w_br_lru, "w_out": w_out,
            "norm_xattn_g": norm_xattn_g, "norm_mem_g": norm_mem_g, "xattn_wq": xattn_wq,
            "xattn_wkv": xattn_wkv, "xattn_wo": xattn_wo, "norm_ffn_g": norm_ffn_g, "ffn_w_up": ffn_w_up,
            "ffn_conv_w": ffn_conv_w, "ffn_conv_b": ffn_conv_b, "ffn_w_down": ffn_w_down,
            "final_norm_g": final_norm_g}


def reference(x, mem, positions, norm_mix_g, w_in, ssm_lambda_re, ssm_lambda_im, ssm_log_step,
              ssm_b_re, ssm_b_im, ssm_c_re, ssm_c_im, ssm_d, ssm_w_glu, ssm_b_glu,
              diff_lq1, diff_lk1, diff_lq2, diff_lk2, diff_subln_g, lru_conv_w, lru_conv_b,
              lru_wa, lru_ba, lru_wx, lru_bx, lru_lambda, w_br_ssm, w_br_attn, w_br_lru, w_out,
              norm_xattn_g, norm_mem_g, xattn_wq, xattn_wkv, xattn_wo, norm_ffn_g, ffn_w_up,
              ffn_conv_w, ffn_conv_b, ffn_w_down, final_norm_g):
    cos, sin = rope_tables(positions)
    for l in range(DEPTH):
        hn = rmsnorm(x, norm_mix_g[l])
        proj = hn @ w_in[l]
        parts = []
        start = 0
        for w in IN_WIDTHS:
            parts.append(proj[..., start:start + w])
            start += w
        u, q, k, v, xr, gr, gates = parts
        y_ssm = s5_branch(u, ssm_lambda_re[l], ssm_lambda_im[l], ssm_log_step[l], ssm_b_re[l], ssm_b_im[l],
                          ssm_c_re[l], ssm_c_im[l], ssm_d[l], ssm_w_glu[l], ssm_b_glu[l])
        lambda_init = 0.8 - 0.6 * math.exp(-0.3 * l)
        y_att = diff_attention_branch(q, k, v, cos, sin, diff_lq1[l], diff_lk1[l], diff_lq2[l], diff_lk2[l],
                                      diff_subln_g[l], lambda_init)
        y_lru = rglru_branch(xr, gr, lru_conv_w[l], lru_conv_b[l], lru_wa[l], lru_ba[l], lru_wx[l], lru_bx[l],
                             lru_lambda[l])
        g = jax.nn.sigmoid(gates)
        merged = (g[..., :D_MODEL] * (y_ssm @ w_br_ssm[l])
                  + g[..., D_MODEL:2 * D_MODEL] * (y_att @ w_br_attn[l])
                  + g[..., 2 * D_MODEL:] * (y_lru @ w_br_lru[l]))
        x = x + merged @ w_out[l]
        x = x + cross_attention(rmsnorm(x, norm_xattn_g[l]), rmsnorm(mem, norm_mem_g[l]),
                                xattn_wq[l], xattn_wkv[l], xattn_wo[l])
        x = x + conv_ffn(rmsnorm(x, norm_ffn_g[l]), ffn_w_up[l], ffn_conv_w[l], ffn_conv_b[l], ffn_w_down[l])
    return rmsnorm(x, final_norm_g)
```

```cpp
#include <hip/hip_runtime.h>
#include <hip/hip_cooperative_groups.h>
#include <cstdio>
namespace cg = cooperative_groups;

#define DI __device__ __forceinline__
typedef unsigned short u16;
typedef __attribute__((ext_vector_type(8))) short bf16x8;
typedef __attribute__((ext_vector_type(16))) float f32x16;
typedef __attribute__((ext_vector_type(4))) unsigned u32x4;
typedef __attribute__((ext_vector_type(2))) unsigned u32x2;
typedef __bf16 bf16v2 __attribute__((ext_vector_type(2)));
typedef float f32v2 __attribute__((ext_vector_type(2)));
#define MFMA(a, b, c) __builtin_amdgcn_mfma_f32_32x32x16_bf16((a), (b), (c), 0, 0, 0)

constexpr int D = 1024, BATCH = 16, SEQ = 2048, DEPTH = 4, T = BATCH * SEQ;
constexpr int NB = 8;
constexpr int TC = NB * SEQ;
constexpr int NCHUNK = BATCH / NB;
constexpr int DIN = 6016, DFF = 2816, DUP = 2 * DFF;
constexpr int C_U = 0, C_Q = 384, C_K = 896, C_V = 1408, C_XR = 1920, C_GR = 2432, C_G = 2944;
constexpr int MEMR = BATCH * 256;
constexpr float EPS = 1e-6f;

constexpr size_t al256(size_t x) { return (x + 255) & ~(size_t)255; }
constexpr size_t W_IN = 0;
constexpr size_t W_GLU = W_IN + (size_t)DIN * 1024;
constexpr size_t W_BRS = W_GLU + 768 * 384;
constexpr size_t W_BRA = W_BRS + 1024 * 384;
constexpr size_t W_BRL = W_BRA + 1024 * 512;
constexpr size_t W_OUT = W_BRL + 1024 * 512;
constexpr size_t W_Q = W_OUT + 1024 * 1024;
constexpr size_t W_KV = W_Q + 1024 * 1024;
constexpr size_t W_O = W_KV + 2048 * 1024;
constexpr size_t W_UP = W_O + 1024 * 1024;
constexpr size_t W_DOWN = W_UP + (size_t)DUP * 1024;
constexpr size_t W_END = W_DOWN + (size_t)1024 * DFF;

constexpr size_t O_BAR = 0;
constexpr size_t O_W = 4096;
constexpr size_t O_M2 = al256(O_W + W_END * 2);
constexpr size_t O_M13 = al256(O_M2 + (size_t)24 * 128 * 256 * 2);
constexpr size_t O_A16 = al256(O_M13 + (size_t)24 * 256 * 384 * 2);
constexpr size_t O_ROPE = al256(O_A16 + 24 * 64 * 8);
constexpr size_t O_MEMN = al256(O_ROPE + (size_t)T * 32 * 8);
constexpr size_t O_KX = al256(O_MEMN + (size_t)MEMR * 1024 * 2);
constexpr size_t O_VTX = al256(O_KX + (size_t)MEMR * 1024 * 2);
constexpr size_t O_HN = al256(O_VTX + (size_t)MEMR * 1024 * 2);
constexpr size_t O_PROJ = al256(O_HN + (size_t)TC * 1024 * 2);
constexpr size_t O_VT = al256(O_PROJ + (size_t)TC * DIN * 2);
constexpr size_t O_YSPRE = al256(O_VT + (size_t)NB * 512 * 2048 * 2);
constexpr size_t O_YS = al256(O_YSPRE + (size_t)TC * 384 * 2);
constexpr size_t O_YA = al256(O_YS + (size_t)TC * 384 * 2);
constexpr size_t O_YL = al256(O_YA + (size_t)TC * 512 * 2);
constexpr size_t O_HLOC = al256(O_YL + (size_t)TC * 512 * 2);
constexpr size_t O_PACC = al256(O_HLOC + (size_t)TC * 512 * 4);
constexpr size_t O_MERGED = al256(O_PACC + (size_t)TC * 512 * 4);
constexpr size_t O_END = al256(O_MERGED + (size_t)TC * 1024 * 2);
constexpr size_t O_QX = O_PROJ;
constexpr size_t O_OX = O_PROJ + (size_t)TC * 1024 * 2;
constexpr size_t O_UP = O_PROJ;
constexpr size_t O_ACT = O_VT;
static_assert(O_ACT + (size_t)TC * DFF * 2 <= O_END, "act alias");
static_assert((size_t)TC * DUP * 2 <= (size_t)TC * DIN * 2, "up alias");
static_assert(O_END <= (size_t)536870912, "workspace");

constexpr int SMEM_BYTES = 128 * 528 + 64;

struct Params {
  const float* in[42];
  float* out;
  char* ws;
};

DI float bf2f(u16 v) { return __uint_as_float(((unsigned)v) << 16); }
DI unsigned pk2(float lo, float hi) {
  f32v2 f = {lo, hi};
  bf16v2 b = __builtin_convertvector(f, bf16v2);
  return __builtin_bit_cast(unsigned, b);
}
DI u16 f2bf(float x) { return (u16)(pk2(x, 0.f) & 0xffffu); }
DI int crow(int i, int hh) { return (i & 3) + 8 * (i >> 2) + 4 * hh; }
DI float sigmoidf_(float x) { return 1.f / (1.f + __expf(-x)); }
DI float gelu_tanh(float x) {
  float u = 0.7978845608028654f * (x + 0.044715f * x * x * x);
  return 0.5f * x * (1.f + tanhf(u));
}
DI int opaque_tid() { int t = threadIdx.x; asm volatile("" : "+v"(t)); return t; }
DI int swap23(int t) { return (t & ~12) | ((t & 4) << 1) | ((t & 8) >> 1); }

DI void gsync(unsigned* bar, unsigned& target) {
  __threadfence();
  __syncthreads();
  if (threadIdx.x == 0) {
    target += gridDim.x;
    __hip_atomic_fetch_add(bar, 1u, __ATOMIC_RELEASE, __HIP_MEMORY_SCOPE_AGENT);
    while (__hip_atomic_load(bar, __ATOMIC_ACQUIRE, __HIP_MEMORY_SCOPE_AGENT) < target) __builtin_amdgcn_s_sleep(2);
  }
  __syncthreads();
  __threadfence();
}

DI void gemm_mainloop(const u16* __restrict__ A, int lda, const u16* __restrict__ B, int ldb, int K,
                      f32x16 (&acc)[2][2], char* smem) {
  const int tid = opaque_tid(), lane = tid & 63, wave = tid >> 6;
  const int wm = wave >> 1, wn = wave & 1, l32 = lane & 31, hh = lane >> 5;
  const int lrow = tid >> 3, lkc = tid & 7;
  const u16* Ap = A + (size_t)lrow * lda + lkc * 8;
  const u16* Bp = B + (size_t)lrow * ldb + lkc * 8;
  char* sA = smem;
  char* sB = smem + 128 * 144;
  const int wofs = lrow * 144 + lkc * 16;
  u32x4 ra[4], rb[4];
#pragma unroll
  for (int i = 0; i < 4; i++) {
    ra[i] = *(const u32x4*)(Ap + (size_t)(32 * i) * lda);
    rb[i] = *(const u32x4*)(Bp + (size_t)(32 * i) * ldb);
  }
  const int nk = K >> 6;
  const int aofs = (wm * 64 + l32) * 144 + hh * 16;
  const int bofs = (wn * 64 + l32) * 144 + hh * 16;
  for (int kt = 0; kt < nk; kt++) {
    __syncthreads();
#pragma unroll
    for (int i = 0; i < 4; i++) {
      *(u32x4*)(sA + wofs + i * 32 * 144) = ra[i];
      *(u32x4*)(sB + wofs + i * 32 * 144) = rb[i];
    }
    __syncthreads();
    if (kt + 1 < nk) {
      Ap += 64; Bp += 64;
#pragma unroll
      for (int i = 0; i < 4; i++) {
        ra[i] = *(const u32x4*)(Ap + (size_t)(32 * i) * lda);
        rb[i] = *(const u32x4*)(Bp + (size_t)(32 * i) * ldb);
      }
    }
#pragma unroll
    for (int s = 0; s < 4; s++) {
      bf16x8 a0 = *(const bf16x8*)(sA + aofs + s * 32);
      bf16x8 a1 = *(const bf16x8*)(sA + aofs + 32 * 144 + s * 32);
      bf16x8 b0 = *(const bf16x8*)(sB + bofs + s * 32);
      bf16x8 b1 = *(const bf16x8*)(sB + bofs + 32 * 144 + s * 32);
      acc[0][0] = MFMA(a0, b0, acc[0][0]);
      acc[0][1] = MFMA(a0, b1, acc[0][1]);
      acc[1][0] = MFMA(a1, b0, acc[1][0]);
      acc[1][1] = MFMA(a1, b1, acc[1][1]);
    }
  }
}

DI void zero_acc(f32x16 (&acc)[2][2]) {
#pragma unroll
  for (int a = 0; a < 2; a++)
#pragma unroll
    for (int b = 0; b < 2; b++)
#pragma unroll
      for (int i = 0; i < 16; i++) acc[a][b][i] = 0.f;
}

enum { EPI_BF16 = 0, EPI_RESID = 1 };

template <int EPI>
DI void gemm_phase(const u16* A, int lda, const u16* Bt, int ldb, int M, int N, int K,
                   u16* Cb, float* Cf, int ldc, char* smem) {
  const int mt = M >> 7, nt = N >> 7;
  const int tid = opaque_tid(), lane = tid & 63, wave = tid >> 6;
  const int wm = wave >> 1, wn = wave & 1, l32 = lane & 31, hh = lane >> 5;
  for (int tile = blockIdx.x; tile < mt * nt; tile += gridDim.x) {
    const int m0 = (tile % mt) << 7, n0 = (tile / mt) << 7;
    f32x16 acc[2][2];
    zero_acc(acc);
    gemm_mainloop(A + (size_t)m0 * lda, lda, Bt + (size_t)n0 * ldb, ldb, K, acc, smem);
#pragma unroll
    for (int mi = 0; mi < 2; mi++)
#pragma unroll
      for (int ni = 0; ni < 2; ni++)
#pragma unroll
        for (int i = 0; i < 16; i++) {
          const int row = m0 + wm * 64 + mi * 32 + crow(i, hh);
          const int col = n0 + wn * 64 + ni * 32 + l32;
          if (EPI == EPI_BF16) Cb[(size_t)row * ldc + col] = f2bf(acc[mi][ni][i]);
          else Cf[(size_t)row * ldc + col] += acc[mi][ni][i];
        }
  }
}

DI void phase_convert_weights(const Params& p, int l, char* smem) {
  u16* wb = (u16*)(p.ws + O_W);
  float* tile = (float*)smem;
  const int tid = opaque_tid();
  constexpr int NT = 5320;
  for (int t = blockIdx.x; t < NT; t += gridDim.x) {
    const float* src; int K, N, base; size_t dst; int perm = 0;
    if (t < 1504)      { src = p.in[4] + (size_t)l * 1024 * DIN;  K = 1024; N = DIN;  dst = W_IN;  base = 0; }
    else if (t < 1576) { src = p.in[13] + (size_t)l * 384 * 768;  K = 384;  N = 768;  dst = W_GLU; base = 1504; perm = 1; }
    else if (t < 1672) { src = p.in[27] + (size_t)l * 384 * 1024; K = 384;  N = 1024; dst = W_BRS; base = 1576; }
    else if (t < 1800) { src = p.in[28] + (size_t)l * 512 * 1024; K = 512;  N = 1024; dst = W_BRA; base = 1672; }
    else if (t < 1928) { src = p.in[29] + (size_t)l * 512 * 1024; K = 512;  N = 1024; dst = W_BRL; base = 1800; }
    else if (t < 2184) { src = p.in[30] + (size_t)l * 1024 * 1024; K = 1024; N = 1024; dst = W_OUT; base = 1928; }
    else if (t < 2440) { src = p.in[33] + (size_t)l * 1024 * 1024; K = 1024; N = 1024; dst = W_Q;   base = 2184; }
    else if (t < 2952) { src = p.in[34] + (size_t)l * 1024 * 2048; K = 1024; N = 2048; dst = W_KV;  base = 2440; }
    else if (t < 3208) { src = p.in[35] + (size_t)l * 1024 * 1024; K = 1024; N = 1024; dst = W_O;   base = 2952; }
    else if (t < 4616) { src = p.in[37] + (size_t)l * 1024 * DUP;  K = 1024; N = DUP;  dst = W_UP;  base = 3208; }
    else               { src = p.in[40] + (size_t)l * DFF * 1024;  K = DFF;  N = 1024; dst = W_DOWN; base = 4616; }
    const int lt = t - base;
    const int ntn = N >> 6;
    const int k0 = (lt / ntn) << 6, n0 = (lt % ntn) << 6;
    __syncthreads();
#pragma unroll
    for (int i = 0; i < 16; i++) {
      const int kk = i * 4 + (tid >> 6), nn = tid & 63;
      tile[kk * 65 + nn] = src[(size_t)(k0 + kk) * N + n0 + nn];
    }
    __syncthreads();
    const int nn = tid >> 2, kq = tid & 3;
    int drow = n0 + nn;
    if (perm) {
      const int c = drow;
      drow = (c < 384) ? ((c >> 5) * 64 + (c & 31)) : (((c - 384) >> 5) * 64 + 32 + ((c - 384) & 31));
    }
    unsigned pk[8];
#pragma unroll
    for (int j = 0; j < 8; j++)
      pk[j] = pk2(tile[(kq * 16 + 2 * j) * 65 + nn], tile[(kq * 16 + 2 * j + 1) * 65 + nn]);
    u32x4* dp = (u32x4*)(wb + dst + (size_t)drow * K + k0 + kq * 16);
    u32x4 v0 = {pk[0], pk[1], pk[2], pk[3]}, v1 = {pk[4], pk[5], pk[6], pk[7]};
    dp[0] = v0; dp[1] = v1;
  }
}

DI void phase_ssm_setup(const Params& p, int l, char* smem) {
  double2* E = (double2*)smem;
  double2* Bb = (double2*)(smem + 17408);
  float2* Cc = (float2*)(smem + 17408 + 16384);
  float* Kt = (float*)(smem + 17408 + 16384 + 8192);
  const int tid = opaque_tid();
  for (int g = blockIdx.x; g < 24; g += gridDim.x) {
    __syncthreads();
    if (tid < 64) {
      const int pp = tid;
      const double lr = p.in[5][(l * 24 + g) * 64 + pp], li = p.in[6][(l * 24 + g) * 64 + pp];
      const double dt = exp((double)p.in[7][l * 24 + g]);
      const double mag = exp(lr * dt);
      const double ar = mag * cos(li * dt), ai = mag * sin(li * dt);
      const double den = lr * lr + li * li, nr = ar - 1.0;
      const double fr = (nr * lr + ai * li) / den, fi = (ai * lr - nr * li) / den;
      double er = 1.0, ei = 0.0;
      for (int k = 0; k <= 16; k++) {
        E[pp * 17 + k] = make_double2(er, ei);
        const double tr = er * ar - ei * ai, ti = er * ai + ei * ar;
        er = tr; ei = ti;
      }
      for (int h = 0; h < 16; h++) {
        const double br = p.in[8][((size_t)(l * 24 + g) * 64 + pp) * 16 + h];
        const double bi = p.in[9][((size_t)(l * 24 + g) * 64 + pp) * 16 + h];
        Bb[pp * 16 + h] = make_double2(fr * br - fi * bi, fr * bi + fi * br);
      }
      ((float2*)(p.ws + O_A16))[g * 64 + pp] = make_float2((float)E[pp * 17 + 16].x, (float)E[pp * 17 + 16].y);
    }
    for (int e = tid; e < 1024; e += 256) {
      Cc[e] = make_float2(p.in[10][(size_t)(l * 24 + g) * 1024 + e], p.in[11][(size_t)(l * 24 + g) * 1024 + e]);
    }
    __syncthreads();
    for (int e = tid; e < 4096; e += 256) {
      const int tau = e >> 8, h = (e >> 4) & 15, h2 = e & 15;
      double s = 0.0;
      for (int pp = 0; pp < 64; pp++) {
        const double2 a = E[pp * 17 + tau];
        const double2 b = Bb[pp * 16 + h2];
        const float2 c = Cc[h * 64 + pp];
        const double zr = a.x * b.x - a.y * b.y, zi = a.x * b.y + a.y * b.x;
        s += (double)c.x * zr - (double)c.y * zi;
      }
      Kt[e] = (float)s;
    }
    __syncthreads();
    u16* m2 = (u16*)(p.ws + O_M2) + (size_t)g * 128 * 256;
    for (int e = tid; e < 128 * 256; e += 256) {
      const int n = e >> 8, kk = e & 255;
      const int j = kk >> 4, h2 = kk & 15, pp = n & 63;
      const double2 a = E[pp * 17 + 15 - j];
      const double2 b = Bb[pp * 16 + h2];
      const double zr = a.x * b.x - a.y * b.y, zi = a.x * b.y + a.y * b.x;
      m2[e] = f2bf((float)(n < 64 ? zr : zi));
    }
    u16* m13 = (u16*)(p.ws + O_M13) + (size_t)g * 256 * 384;
    for (int e = tid; e < 256 * 384; e += 256) {
      const int n = e / 384, kk = e - n * 384;
      const int i = n >> 4, h = n & 15;
      float v;
      if (kk < 256) {
        const int j = kk >> 4, h2 = kk & 15;
        v = (j <= i) ? Kt[((i - j) << 8) + (h << 4) + h2] : 0.f;
      } else {
        const int q = kk - 256, pp = q & 63;
        const double2 a = E[pp * 17 + i + 1];
        const float2 c = Cc[h * 64 + pp];
        const double zr = (double)c.x * a.x - (double)c.y * a.y, zi = (double)c.x * a.y + (double)c.y * a.x;
        v = (float)(q < 64 ? zr : -zi);
      }
      m13[e] = f2bf(v);
    }
  }
}

DI void phase_init(const Params& p) {
  const size_t gtid = (size_t)blockIdx.x * 256 + opaque_tid(), gsz = (size_t)gridDim.x * 256;
  float2* rope = (float2*)(p.ws + O_ROPE);
  const int* pos = (const int*)p.in[2];
  for (size_t e = gtid; e < (size_t)T * 32; e += gsz) {
    const int t = (int)(e >> 5), d = (int)(e & 31);
    const float inv = (float)exp(-9.210340371976184 * (double)(2 * d) / 64.0);
    const float ang = (float)pos[t] * inv;
    rope[e] = make_float2((float)cos((double)ang), (float)sin((double)ang));
  }
  const float4* xs = (const float4*)p.in[0];
  float4* xd = (float4*)p.out;
  for (size_t e = gtid; e < (size_t)T * 256; e += gsz) xd[e] = xs[e];
}

DI void rmsnorm_rows(const float* __restrict__ x, const float* __restrict__ g, u16* __restrict__ out, int nrows) {
  const int tid = opaque_tid();
  const int lane = tid & 63;
  const int gw = blockIdx.x * 4 + (tid >> 6), nw = gridDim.x * 4;
  for (int r = gw; r < nrows; r += nw) {
    const float4* xr = (const float4*)(x + (size_t)r * 1024);
    float4 v[4];
    float ss = 0.f;
#pragma unroll
    for (int i = 0; i < 4; i++) {
      v[i] = xr[lane + 64 * i];
      ss += v[i].x * v[i].x + v[i].y * v[i].y + v[i].z * v[i].z + v[i].w * v[i].w;
    }
#pragma unroll
    for (int o = 32; o > 0; o >>= 1) ss += __shfl_xor(ss, o);
    const float rs = rsqrtf(ss * (1.f / 1024.f) + EPS);
#pragma unroll
    for (int i = 0; i < 4; i++) {
      const float4 gg = ((const float4*)g)[lane + 64 * i];
      u32x2 o2 = {pk2(v[i].x * rs * gg.x, v[i].y * rs * gg.y), pk2(v[i].z * rs * gg.z, v[i].w * rs * gg.w)};
      *(u32x2*)(out + (size_t)r * 1024 + (lane + 64 * i) * 4) = o2;
    }
  }
}

DI void final_norm(float* x, const float* __restrict__ g) {
  const int tid = opaque_tid();
  const int lane = tid & 63;
  const int gw = blockIdx.x * 4 + (tid >> 6), nw = gridDim.x * 4;
  for (int r = gw; r < T; r += nw) {
    float4* xr = (float4*)(x + (size_t)r * 1024);
    float4 v[4];
    float ss = 0.f;
#pragma unroll
    for (int i = 0; i < 4; i++) {
      v[i] = xr[lane + 64 * i];
      ss += v[i].x * v[i].x + v[i].y * v[i].y + v[i].z * v[i].z + v[i].w * v[i].w;
    }
#pragma unroll
    for (int o = 32; o > 0; o >>= 1) ss += __shfl_xor(ss, o);
    const float rs = rsqrtf(ss * (1.f / 1024.f) + EPS);
#pragma unroll
    for (int i = 0; i < 4; i++) {
      const float4 gg = ((const float4*)g)[lane + 64 * i];
      xr[lane + 64 * i] = make_float4(v[i].x * rs * gg.x, v[i].y * rs * gg.y, v[i].z * rs * gg.z, v[i].w * rs * gg.w);
    }
  }
}

DI void phase_proj(const Params& p, int chunk, char* smem) {
  const u16* A = (const u16*)(p.ws + O_HN);
  const u16* Bt = (const u16*)(p.ws + O_W) + W_IN;
  u16* proj = (u16*)(p.ws + O_PROJ);
  u16* vt = (u16*)(p.ws + O_VT);
  const float2* rope = (const float2*)(p.ws + O_ROPE) + (size_t)chunk * TC * 32;
  constexpr int mt = TC / 128, nt = DIN / 128;
  const int tid = opaque_tid(), lane = tid & 63, wave = tid >> 6;
  const int wm = wave >> 1, wn = wave & 1, l32 = lane & 31, hh = lane >> 5;
  for (int tile = blockIdx.x; tile < mt * nt; tile += gridDim.x) {
    const int m0 = (tile % mt) << 7, n0 = (tile / mt) << 7;
    f32x16 acc[2][2];
    zero_acc(acc);
    gemm_mainloop(A + (size_t)m0 * 1024, 1024, Bt + (size_t)n0 * 1024, 1024, 1024, acc, smem);
    if (n0 >= C_Q && n0 < C_V) {
#pragma unroll
      for (int mi = 0; mi < 2; mi++)
#pragma unroll
        for (int i = 0; i < 16; i++) {
          const int row = m0 + wm * 64 + mi * 32 + crow(i, hh);
          const float2 cs = rope[(size_t)row * 32 + l32];
          const float x1 = acc[mi][0][i], x2 = acc[mi][1][i];
          const int col = n0 + wn * 64 + l32;
          proj[(size_t)row * DIN + col] = f2bf(x1 * cs.x - x2 * cs.y);
          proj[(size_t)row * DIN + col + 32] = f2bf(x2 * cs.x + x1 * cs.y);
        }
    } else if (n0 >= C_V && n0 < C_XR) {
#pragma unroll
      for (int mi = 0; mi < 2; mi++)
#pragma unroll
        for (int ni = 0; ni < 2; ni++)
#pragma unroll
          for (int g4 = 0; g4 < 4; g4++) {
            const int row = m0 + wm * 64 + mi * 32 + 8 * g4 + 4 * hh;
            const int bl = row >> 11, t = row & 2047;
            const int c = n0 - C_V + wn * 64 + ni * 32 + l32;
            u32x2 v = {pk2(acc[mi][ni][4 * g4], acc[mi][ni][4 * g4 + 1]), pk2(acc[mi][ni][4 * g4 + 2], acc[mi][ni][4 * g4 + 3])};
            *(u32x2*)(vt + ((size_t)(bl * 512 + c)) * 2048 + swap23(t)) = v;
          }
    } else {
#pragma unroll
      for (int mi = 0; mi < 2; mi++)
#pragma unroll
        for (int ni = 0; ni < 2; ni++)
#pragma unroll
          for (int i = 0; i < 16; i++) {
            const int row = m0 + wm * 64 + mi * 32 + crow(i, hh);
            const int col = n0 + wn * 64 + ni * 32 + l32;
            proj[(size_t)row * DIN + col] = f2bf(acc[mi][ni][i]);
          }
    }
  }
}

DI void phase_memkv(const Params& p, char* smem) {
  const u16* A = (const u16*)(p.ws + O_MEMN);
  const u16* Bt = (const u16*)(p.ws + O_W) + W_KV;
  u16* kx = (u16*)(p.ws + O_KX);
  u16* vtx = (u16*)(p.ws + O_VTX);
  constexpr int mt = MEMR / 128, nt = 2048 / 128;
  const int tid = opaque_tid(), lane = tid & 63, wave = tid >> 6;
  const int wm = wave >> 1, wn = wave & 1, l32 = lane & 31, hh = lane >> 5;
  for (int tile = blockIdx.x; tile < mt * nt; tile += gridDim.x) {
    const int m0 = (tile % mt) << 7, n0 = (tile / mt) << 7;
    f32x16 acc[2][2];
    zero_acc(acc);
    gemm_mainloop(A + (size_t)m0 * 1024, 1024, Bt + (size_t)n0 * 1024, 1024, 1024, acc, smem);
    if (n0 < 1024) {
#pragma unroll
      for (int mi = 0; mi < 2; mi++)
#pragma unroll
        for (int ni = 0; ni < 2; ni++)
#pragma unroll
          for (int i = 0; i < 16; i++) {
            const int row = m0 + wm * 64 + mi * 32 + crow(i, hh);
            const int col = n0 + wn * 64 + ni * 32 + l32;
            kx[(size_t)row * 1024 + col] = f2bf(acc[mi][ni][i]);
          }
    } else {
#pragma unroll
      for (int mi = 0; mi < 2; mi++)
#pragma unroll
        for (int ni = 0; ni < 2; ni++)
#pragma unroll
          for (int g4 = 0; g4 < 4; g4++) {
            const int row = m0 + wm * 64 + mi * 32 + 8 * g4 + 4 * hh;
            const int b = row >> 8, t = row & 255;
            const int c = n0 - 1024 + wn * 64 + ni * 32 + l32;
            u32x2 v = {pk2(acc[mi][ni][4 * g4], acc[mi][ni][4 * g4 + 1]), pk2(acc[mi][ni][4 * g4 + 2], acc[mi][ni][4 * g4 + 3])};
            *(u32x2*)(vtx + ((size_t)(b * 1024 + c)) * 256 + swap23(t)) = v;
          }
    }
  }
}

DI void attn_item(const Params& p, int l, int bl, int h, int qb, char* smem) {
  const u16* proj = (const u16*)(p.ws + O_PROJ);
  const u16* vt = (const u16*)(p.ws + O_VT);
  u16* ya = (u16*)(p.ws + O_YA);
  const int tid = opaque_tid(), lane = tid & 63, wave = tid >> 6;
  const int l32 = lane & 31, hh = lane >> 5;
  const int qrow0 = qb * 128 + wave * 32;
  const size_t rowbase = (size_t)bl * 2048;
  char* sK = smem;
  char* sV = smem + 64 * 144;
  const float sc = 0.125f * 1.4426950408889634f;
  f32x16 Osave[4];
  float d1 = 0.f, d2 = 0.f;
  for (int i = 0; i < 64; i++) {
    d1 += p.in[15][l * 64 + i] * p.in[16][l * 64 + i];
    d2 += p.in[17][l * 64 + i] * p.in[18][l * 64 + i];
  }
  const float lam_init = 0.8f - 0.6f * expf(-0.3f * (float)l);
  const float lam = expf(d1) - expf(d2) + lam_init;

  for (int comp = 0; comp < 2; comp++) {
    bf16x8 Qf[4];
    {
      const u16* qp = proj + (rowbase + qrow0 + l32) * DIN + C_Q + h * 128 + comp * 64 + hh * 8;
#pragma unroll
      for (int s = 0; s < 4; s++) Qf[s] = *(const bf16x8*)(qp + s * 16);
    }
    f32x16 O[4];
#pragma unroll
    for (int a = 0; a < 4; a++)
#pragma unroll
      for (int i = 0; i < 16; i++) O[a][i] = 0.f;
    float m_run = -1e30f, l_run = 0.f;
    const int nkt = 2 * (qb + 1);
    const u16* kp = proj + (rowbase + (tid >> 3)) * DIN + C_K + h * 128 + comp * 64 + (tid & 7) * 8;
    const u16* vp = vt + ((size_t)(bl * 512 + h * 128 + (tid >> 3))) * 2048 + (tid & 7) * 8;
    u32x4 rk[2], rv[4];
#pragma unroll
    for (int i = 0; i < 2; i++) rk[i] = *(const u32x4*)(kp + (size_t)(32 * i) * DIN);
#pragma unroll
    for (int i = 0; i < 4; i++) rv[i] = *(const u32x4*)(vp + (size_t)(32 * i) * 2048);
    const int wofs = (tid >> 3) * 144 + (tid & 7) * 16;
    for (int kt = 0; kt < nkt; kt++) {
      __syncthreads();
#pragma unroll
      for (int i = 0; i < 2; i++) *(u32x4*)(sK + wofs + i * 32 * 144) = rk[i];
#pragma unroll
      for (int i = 0; i < 4; i++) *(u32x4*)(sV + wofs + i * 32 * 144) = rv[i];
      __syncthreads();
      if (kt + 1 < nkt) {
        kp += (size_t)64 * DIN; vp += 64;
#pragma unroll
        for (int i = 0; i < 2; i++) rk[i] = *(const u32x4*)(kp + (size_t)(32 * i) * DIN);
#pragma unroll
        for (int i = 0; i < 4; i++) rv[i] = *(const u32x4*)(vp + (size_t)(32 * i) * 2048);
      }
      if (kt * 64 <= qrow0 + 31) {
        f32x16 S[2];
#pragma unroll
        for (int a = 0; a < 2; a++)
#pragma unroll
          for (int i = 0; i < 16; i++) S[a][i] = 0.f;
#pragma unroll
        for (int kt2 = 0; kt2 < 2; kt2++)
#pragma unroll
          for (int s = 0; s < 4; s++) {
            bf16x8 a = *(const bf16x8*)(sK + (kt2 * 32 + l32) * 144 + s * 32 + hh * 16);
            S[kt2] = MFMA(a, Qf[s], S[kt2]);
          }
        if (kt * 64 + 63 > qrow0) {
#pragma unroll
          for (int kt2 = 0; kt2 < 2; kt2++)
#pragma unroll
            for (int i = 0; i < 16; i++) {
              const int key = kt * 64 + kt2 * 32 + crow(i, hh);
              if (key > qrow0 + l32) S[kt2][i] = -INFINITY;
            }
        }
        float mx = -INFINITY;
#pragma unroll
        for (int kt2 = 0; kt2 < 2; kt2++)
#pragma unroll
          for (int i = 0; i < 16; i++) mx = fmaxf(mx, S[kt2][i]);
        mx = fmaxf(mx, __shfl_xor(mx, 32));
        const float m_new = fmaxf(m_run, mx * sc);
        const float alpha = __builtin_amdgcn_exp2f(m_run - m_new);
        m_run = m_new;
        float ps = 0.f;
#pragma unroll
        for (int kt2 = 0; kt2 < 2; kt2++)
#pragma unroll
          for (int i = 0; i < 16; i++) {
            const float pv = __builtin_amdgcn_exp2f(S[kt2][i] * sc - m_new);
            S[kt2][i] = pv;
            ps += pv;
          }
        l_run = l_run * alpha + ps;
#pragma unroll
        for (int a = 0; a < 4; a++)
#pragma unroll
          for (int i = 0; i < 16; i++) O[a][i] *= alpha;
        bf16x8 Pf[4];
#pragma unroll
        for (int kk = 0; kk < 4; kk++) {
          const int kt2 = kk >> 1, s2 = kk & 1;
          u32x4 pk = {pk2(S[kt2][8 * s2 + 0], S[kt2][8 * s2 + 1]), pk2(S[kt2][8 * s2 + 2], S[kt2][8 * s2 + 3]),
                      pk2(S[kt2][8 * s2 + 4], S[kt2][8 * s2 + 5]), pk2(S[kt2][8 * s2 + 6], S[kt2][8 * s2 + 7])};
          Pf[kk] = __builtin_bit_cast(bf16x8, pk);
        }
#pragma unroll
        for (int dvt = 0; dvt < 4; dvt++)
#pragma unroll
          for (int kk = 0; kk < 4; kk++) {
            bf16x8 a = *(const bf16x8*)(sV + (dvt * 32 + l32) * 144 + kk * 32 + hh * 16);
            O[dvt] = MFMA(a, Pf[kk], O[dvt]);
          }
      }
    }
    const float ltot = l_run + __shfl_xor(l_run, 32);
    const float invl = 1.f / ltot;
    if (comp == 0) {
#pragma unroll
      for (int a = 0; a < 4; a++)
#pragma unroll
        for (int i = 0; i < 16; i++) Osave[a][i] = O[a][i] * invl;
    } else {
      float ss = 0.f;
#pragma unroll
      for (int a = 0; a < 4; a++)
#pragma unroll
        for (int i = 0; i < 16; i++) {
          const float o = Osave[a][i] - lam * (O[a][i] * invl);
          Osave[a][i] = o;
          ss += o * o;
        }
      ss += __shfl_xor(ss, 32);
      const float rs = rsqrtf(ss * (1.f / 128.f) + EPS) * (1.f - lam_init);
      const float* sg = p.in[19] + l * 128;
      u16* yp = ya + (rowbase + qrow0 + l32) * 512 + h * 128;
#pragma unroll
      for (int a = 0; a < 4; a++)
#pragma unroll
        for (int g4 = 0; g4 < 4; g4++) {
          const int dv = a * 32 + 8 * g4 + 4 * hh;
          const float4 gg = *(const float4*)(sg + dv);
          u32x2 v = {pk2(Osave[a][4 * g4] * rs * gg.x, Osave[a][4 * g4 + 1] * rs * gg.y),
                     pk2(Osave[a][4 * g4 + 2] * rs * gg.z, Osave[a][4 * g4 + 3] * rs * gg.w)};
          *(u32x2*)(yp + dv) = v;
        }
    }
  }
}

DI void ssm_item(const Params& p, int l, int bl, int g, char* smem) {
  const u16* proj = (const u16*)(p.ws + O_PROJ);
  const u16* m2 = (const u16*)(p.ws + O_M2) + (size_t)g * 128 * 256;
  const u16* m13 = (const u16*)(p.ws + O_M13) + (size_t)g * 256 * 384;
  u16* yspre = (u16*)(p.ws + O_YSPRE);
  const int tid = opaque_tid(), lane = tid & 63, wave = tid >> 6;
  const int l32 = lane & 31, hh = lane >> 5;
  const size_t rowbase = (size_t)bl * 2048;
  const u16* ua = proj + (rowbase + (size_t)(32 * wave + l32) * 16) * DIN + C_U + g * 16 + hh * 8;
  __syncthreads();
  {
    f32x16 acc[4];
#pragma unroll
    for (int a = 0; a < 4; a++)
#pragma unroll
      for (int i = 0; i < 16; i++) acc[a][i] = 0.f;
#pragma unroll 4
    for (int s = 0; s < 16; s++) {
      bf16x8 a = *(const bf16x8*)(ua + (size_t)s * DIN);
#pragma unroll
      for (int nt = 0; nt < 4; nt++) {
        bf16x8 b = *(const bf16x8*)(m2 + (size_t)(nt * 32 + l32) * 256 + s * 16 + hh * 8);
        acc[nt] = MFMA(a, b, acc[nt]);
      }
    }
#pragma unroll
    for (int nt = 0; nt < 4; nt++)
#pragma unroll
      for (int i = 0; i < 16; i++) {
        const int c = 32 * wave + crow(i, hh);
        *(float*)(smem + c * 528 + (nt * 32 + l32) * 4) = acc[nt][i];
      }
  }
  __syncthreads();
  if (wave == 0) {
    const float2 a16 = ((const float2*)(p.ws + O_A16))[g * 64 + lane];
    float sr = 0.f, si = 0.f;
    float nlr = *(volatile float*)(smem + lane * 4), nli = *(volatile float*)(smem + 256 + lane * 4);
    for (int c = 0; c < 128; c++) {
      const float lr = nlr, li = nli;
      if (c + 1 < 128) {
        nlr = *(volatile float*)(smem + (c + 1) * 528 + lane * 4);
        nli = *(volatile float*)(smem + (c + 1) * 528 + 256 + lane * 4);
      }
      asm volatile("" ::: "memory");
      *(volatile u16*)(smem + c * 528 + lane * 2) = f2bf(sr);
      *(volatile u16*)(smem + c * 528 + 128 + lane * 2) = f2bf(si);
      asm volatile("" ::: "memory");
      const float nr = a16.x * sr - a16.y * si + lr;
      const float ni = a16.x * si + a16.y * sr + li;
      sr = nr; si = ni;
    }
  }
  __syncthreads();
  const float* dsk = p.in[12] + l * 384 + g * 16;
#pragma unroll 1
  for (int half = 0; half < 2; half++) {
    f32x16 acc[4];
#pragma unroll
    for (int a = 0; a < 4; a++)
#pragma unroll
      for (int i = 0; i < 16; i++) acc[a][i] = 0.f;
#pragma unroll 4
    for (int s = 0; s < 16; s++) {
      bf16x8 a = *(const bf16x8*)(ua + (size_t)s * DIN);
#pragma unroll
      for (int nt = 0; nt < 4; nt++) {
        if (s <= half * 8 + nt * 2 + 1) {
          bf16x8 b = *(const bf16x8*)(m13 + (size_t)(half * 128 + nt * 32 + l32) * 384 + s * 16 + hh * 8);
          acc[nt] = MFMA(a, b, acc[nt]);
        }
      }
    }
#pragma unroll 4
    for (int s = 0; s < 8; s++) {
      bf16x8 a = *(const bf16x8*)(smem + (32 * wave + l32) * 528 + s * 32 + hh * 16);
#pragma unroll
      for (int nt = 0; nt < 4; nt++) {
        bf16x8 b = *(const bf16x8*)(m13 + (size_t)(half * 128 + nt * 32 + l32) * 384 + 256 + s * 16 + hh * 8);
        acc[nt] = MFMA(a, b, acc[nt]);
      }
    }
#pragma unroll
    for (int nt = 0; nt < 4; nt++) {
      const int n = half * 128 + nt * 32 + l32;
      const int ti = n >> 4, hc = n & 15;
      const float dk = dsk[hc];
#pragma unroll
      for (int i = 0; i < 16; i++) {
        const int c = 32 * wave + crow(i, hh);
        const size_t tok = rowbase + (size_t)c * 16 + ti;
        const float u = bf2f(proj[tok * DIN + C_U + g * 16 + hc]);
        const float y = acc[nt][i] + dk * u;
        yspre[tok * 384 + g * 16 + hc] = f2bf(gelu_tanh(y));
      }
    }
  }
}

DI void lru_item(const Params& p, int l, int bl, int tc, int hg) {
  const u16* proj = (const u16*)(p.ws + O_PROJ);
  float* hloc = (float*)(p.ws + O_HLOC);
  float* pacc = (float*)(p.ws + O_PACC);
  const int tid = opaque_tid(), lane = tid & 63, wave = tid >> 6;
  const int head = hg * 4 + wave, ch = head * 64 + lane;
  float wa[64], wx[64];
  const float* wap = p.in[22] + ((size_t)(l * 8 + head) * 64) * 64 + lane;
  const float* wxp = p.in[24] + ((size_t)(l * 8 + head) * 64) * 64 + lane;
#pragma unroll
  for (int i = 0; i < 64; i++) { wa[i] = wap[i * 64]; wx[i] = wxp[i * 64]; }
  const float cw0 = p.in[20][(l * 4 + 0) * 512 + ch], cw1 = p.in[20][(l * 4 + 1) * 512 + ch];
  const float cw2 = p.in[20][(l * 4 + 2) * 512 + ch], cw3 = p.in[20][(l * 4 + 3) * 512 + ch];
  const float cb = p.in[21][l * 512 + ch], ba = p.in[23][l * 512 + ch], bx = p.in[25][l * 512 + ch];
  const float lamv = p.in[26][l * 512 + ch];
  const float sp = (lamv < 0.f) ? (-lamv + log1pf(expf(lamv))) : log1pf(expf(-lamv));
  const int t0 = tc * 64;
  const size_t rowbase = (size_t)bl * 2048;
  const u16* xp = proj + (rowbase + t0) * DIN + C_XR + ch;
  float xm3 = 0.f, xm2 = 0.f, xm1 = 0.f;
  if (t0 > 0) {
    xm3 = bf2f(*(xp - (size_t)3 * DIN));
    xm2 = bf2f(*(xp - (size_t)2 * DIN));
    xm1 = bf2f(*(xp - (size_t)1 * DIN));
  }
  float hl = 0.f, P = 1.f;
  float xn = bf2f(xp[0]);
#pragma unroll 1
  for (int tt = 0; tt < 64; tt++) {
    const float x0 = xn;
    if (tt + 1 < 64) xn = bf2f(xp[(size_t)(tt + 1) * DIN]);
    const float xc = cw0 * xm3 + cw1 * xm2 + cw2 * xm1 + cw3 * x0 + cb;
    xm3 = xm2; xm2 = xm1; xm1 = x0;
    float ra = ba, rx = bx;
#pragma unroll
    for (int i = 0; i < 64; i++) {
      const float xi = __int_as_float(__builtin_amdgcn_readlane(__float_as_int(xc), i));
      ra += xi * wa[i];
      rx += xi * wx[i];
    }
    const float r = sigmoidf_(ra), ig = sigmoidf_(rx);
    const float log_a = -8.f * r * sp;
    const float a = __expf(log_a);
    const float bq = sqrtf(fmaxf(-expm1f(2.f * log_a), 0.f)) * (ig * xc);
    hl = a * hl + bq;
    P *= a;
    const size_t o = (rowbase + t0 + tt) * 512 + ch;
    hloc[o] = hl;
    pacc[o] = P;
  }
}

DI void phase_mixers(const Params& p, int l, unsigned* ctr, char* smem) {
  volatile int* s_item_p = (volatile int*)(smem + 128 * 528);
  constexpr int N_ATT = NB * 4 * 16, N_SSM = NB * 24, N_LRU = NB * 32 * 2;
  constexpr int A1 = NB * 4 * 11, A2 = NB * 4 * 2, A3 = NB * 4 * 3;
  constexpr int TOT = N_ATT + N_SSM + N_LRU;
  for (;;) {
    __syncthreads();
    if (threadIdx.x == 0) *s_item_p = (int)atomicAdd(ctr, 1u);
    __syncthreads();
    int it = *s_item_p;
    if (it >= TOT) break;
    int kind, idx;
    if (it < A1) { kind = 0; idx = it; }
    else if (it < A1 + N_LRU) { kind = 1; idx = it - A1; }
    else if (it < A1 + N_LRU + A2) { kind = 0; idx = it - N_LRU; }
    else if (it < A1 + N_LRU + A2 + N_SSM) { kind = 2; idx = it - (A1 + N_LRU + A2); }
    else { kind = 0; idx = it - N_LRU - N_SSM; }
    if (kind == 0) {
      const int qb = 15 - idx / (NB * 4), r = idx % (NB * 4);
      attn_item(p, l, r >> 2, r & 3, qb, smem);
    } else if (kind == 1) {
      lru_item(p, l, idx / 64, (idx >> 1) & 31, idx & 1);
    } else {
      ssm_item(p, l, idx / 24, idx % 24, smem);
    }
  }
  (void)A3;
}

DI void phase_glu_lru2(const Params& p, int l, char* smem) {
  {
    const u16* A = (const u16*)(p.ws + O_YSPRE);
    const u16* Bt = (const u16*)(p.ws + O_W) + W_GLU;
    u16* ys = (u16*)(p.ws + O_YS);
    const float* bg = p.in[14] + l * 768;
    constexpr int mt = TC / 128, nt = 768 / 128;
    const int tid = opaque_tid(), lane = tid & 63, wave = tid >> 6;
    const int wm = wave >> 1, wn = wave & 1, l32 = lane & 31, hh = lane >> 5;
    for (int tile = blockIdx.x; tile < mt * nt; tile += gridDim.x) {
      const int m0 = (tile % mt) << 7, n0 = (tile / mt) << 7;
      f32x16 acc[2][2];
      zero_acc(acc);
      gemm_mainloop(A + (size_t)m0 * 384, 384, Bt + (size_t)n0 * 384, 384, 384, acc, smem);
      const int c = ((n0 >> 6) + wn) * 32 + l32;
      const float b1 = bg[c], b2 = bg[384 + c];
#pragma unroll
      for (int mi = 0; mi < 2; mi++)
#pragma unroll
        for (int i = 0; i < 16; i++) {
          const int row = m0 + wm * 64 + mi * 32 + crow(i, hh);
          const float v = (acc[mi][0][i] + b1) * sigmoidf_(acc[mi][1][i] + b2);
          ys[(size_t)row * 384 + c] = f2bf(v);
        }
    }
  }
  {
    const u16* proj = (const u16*)(p.ws + O_PROJ);
    const float* hloc = (const float*)(p.ws + O_HLOC);
    const float* pacc = (const float*)(p.ws + O_PACC);
    u16* yl = (u16*)(p.ws + O_YL);
    constexpr int NI = NB * 32 * 2;
    const int tid2 = opaque_tid();
    for (int it = blockIdx.x; it < NI; it += gridDim.x) {
      const int bl = it / 64, tc = (it >> 1) & 31, ch = (it & 1) * 256 + tid2;
      const size_t rowbase = (size_t)bl * 2048;
      float hin = 0.f;
      for (int c = 0; c < tc; c++) {
        const size_t o = (rowbase + c * 64 + 63) * 512 + ch;
        hin = pacc[o] * hin + hloc[o];
      }
      for (int tt = 0; tt < 64; tt++) {
        const size_t row = rowbase + tc * 64 + tt;
        const float hv = hloc[row * 512 + ch] + pacc[row * 512 + ch] * hin;
        const float gr = bf2f(proj[row * DIN + C_GR + ch]);
        yl[row * 512 + ch] = f2bf(hv * gelu_tanh(gr));
      }
    }
  }
}

DI void phase_merge(const Params& p, char* smem) {
  const u16* proj = (const u16*)(p.ws + O_PROJ);
  const u16* wb = (const u16*)(p.ws + O_W);
  u16* merged = (u16*)(p.ws + O_MERGED);
  constexpr int mt = TC / 128, nt = 1024 / 128;
  const int tid = opaque_tid(), lane = tid & 63, wave = tid >> 6;
  const int wm = wave >> 1, wn = wave & 1, l32 = lane & 31, hh = lane >> 5;
  for (int tile = blockIdx.x; tile < mt * nt; tile += gridDim.x) {
    const int m0 = (tile % mt) << 7, n0 = (tile / mt) << 7;
    f32x16 tot[2][2];
    zero_acc(tot);
#pragma unroll 1
    for (int br = 0; br < 3; br++) {
      const u16* A = (const u16*)(p.ws + (br == 0 ? O_YS : (br == 1 ? O_YA : O_YL)));
      const int K = (br == 0) ? 384 : 512;
      const u16* Bt = wb + (br == 0 ? W_BRS : (br == 1 ? W_BRA : W_BRL));
      f32x16 acc[2][2];
      zero_acc(acc);
      gemm_mainloop(A + (size_t)m0 * K, K, Bt + (size_t)n0 * K, K, K, acc, smem);
#pragma unroll
      for (int mi = 0; mi < 2; mi++)
#pragma unroll
        for (int ni = 0; ni < 2; ni++)
#pragma unroll
          for (int i = 0; i < 16; i++) {
            const int row = m0 + wm * 64 + mi * 32 + crow(i, hh);
            const int col = n0 + wn * 64 + ni * 32 + l32;
            const float gt = bf2f(proj[(size_t)row * DIN + C_G + br * 1024 + col]);
            tot[mi][ni][i] += sigmoidf_(gt) * acc[mi][ni][i];
          }
    }
#pragma unroll
    for (int mi = 0; mi < 2; mi++)
#pragma unroll
      for (int ni = 0; ni < 2; ni++)
#pragma unroll
        for (int i = 0; i < 16; i++) {
          const int row = m0 + wm * 64 + mi * 32 + crow(i, hh);
          const int col = n0 + wn * 64 + ni * 32 + l32;
          merged[(size_t)row * 1024 + col] = f2bf(tot[mi][ni][i]);
        }
  }
}

DI void phase_xattn(const Params& p, int chunk, char* smem) {
  const u16* qx = (const u16*)(p.ws + O_QX);
  const u16* kx = (const u16*)(p.ws + O_KX);
  const u16* vtx = (const u16*)(p.ws + O_VTX);
  u16* ox = (u16*)(p.ws + O_OX);
  const int tid = opaque_tid(), lane = tid & 63, wave = tid >> 6;
  const int l32 = lane & 31, hh = lane >> 5;
  constexpr int NI = (TC / 128) * 4;
  const float sc = 0.0625f * 1.4426950408889634f;
  for (int it = blockIdx.x; it < NI; it += gridDim.x) {
    const int head = it & 3, rb = it >> 2;
    const int r0 = rb * 128 + wave * 32;
    const int b = chunk * NB + (rb >> 4);
    bf16x8 Qf[16];
    {
      const u16* qp = qx + (size_t)(r0 + l32) * 1024 + head * 256 + hh * 8;
#pragma unroll
      for (int s = 0; s < 16; s++) Qf[s] = *(const bf16x8*)(qp + s * 16);
    }
    f32x16 S[8];
#pragma unroll
    for (int a = 0; a < 8; a++)
#pragma unroll
      for (int i = 0; i < 16; i++) S[a][i] = 0.f;
#pragma unroll
    for (int ks = 0; ks < 4; ks++) {
      __syncthreads();
#pragma unroll
      for (int i = 0; i < 8; i++) {
        const int c = tid + 256 * i, row = c >> 5, kc = c & 31;
        *(u32x4*)(smem + row * 528 + kc * 16) =
            *(const u32x4*)(kx + (size_t)(b * 256 + ks * 64 + row) * 1024 + head * 256 + kc * 8);
      }
      __syncthreads();
#pragma unroll
      for (int kt2 = 0; kt2 < 2; kt2++)
#pragma unroll
        for (int s = 0; s < 16; s++) {
          bf16x8 a = *(const bf16x8*)(smem + (kt2 * 32 + l32) * 528 + s * 32 + hh * 16);
          S[ks * 2 + kt2] = MFMA(a, Qf[s], S[ks * 2 + kt2]);
        }
    }
    float mx = -INFINITY;
#pragma unroll
    for (int a = 0; a < 8; a++)
#pragma unroll
      for (int i = 0; i < 16; i++) mx = fmaxf(mx, S[a][i]);
    mx = fmaxf(mx, __shfl_xor(mx, 32));
    const float mm = mx * sc;
    float ps = 0.f;
#pragma unroll
    for (int a = 0; a < 8; a++)
#pragma unroll
      for (int i = 0; i < 16; i++) {
        const float pv = __builtin_amdgcn_exp2f(S[a][i] * sc - mm);
        S[a][i] = pv;
        ps += pv;
      }
    ps += __shfl_xor(ps, 32);
    const float invl = 1.f / ps;
    bf16x8 Pf[16];
#pragma unroll
    for (int kk = 0; kk < 16; kk++) {
      const int a = kk >> 1, s2 = kk & 1;
      u32x4 pk = {pk2(S[a][8 * s2 + 0] * invl, S[a][8 * s2 + 1] * invl), pk2(S[a][8 * s2 + 2] * invl, S[a][8 * s2 + 3] * invl),
                  pk2(S[a][8 * s2 + 4] * invl, S[a][8 * s2 + 5] * invl), pk2(S[a][8 * s2 + 6] * invl, S[a][8 * s2 + 7] * invl)};
      Pf[kk] = __builtin_bit_cast(bf16x8, pk);
    }
#pragma unroll 1
    for (int dvt = 0; dvt < 8; dvt++) {
      __syncthreads();
#pragma unroll
      for (int i = 0; i < 4; i++) {
        const int c = tid + 256 * i, row = c >> 5, kc = c & 31;
        *(u32x4*)(smem + row * 528 + kc * 16) =
            *(const u32x4*)(vtx + (size_t)(b * 1024 + head * 256 + dvt * 32 + row) * 256 + kc * 8);
      }
      __syncthreads();
      f32x16 O;
#pragma unroll
      for (int i = 0; i < 16; i++) O[i] = 0.f;
#pragma unroll
      for (int kk = 0; kk < 16; kk++) {
        bf16x8 a = *(const bf16x8*)(smem + l32 * 528 + kk * 32 + hh * 16);
        O = MFMA(a, Pf[kk], O);
      }
      u16* op = ox + (size_t)(r0 + l32) * 1024 + head * 256 + dvt * 32;
#pragma unroll
      for (int g4 = 0; g4 < 4; g4++) {
        u32x2 v = {pk2(O[4 * g4], O[4 * g4 + 1]), pk2(O[4 * g4 + 2], O[4 * g4 + 3])};
        *(u32x2*)(op + 8 * g4 + 4 * hh) = v;
      }
    }
  }
}

DI void phase_ffn_act(const Params& p, int l) {
  const u16* up = (const u16*)(p.ws + O_UP);
  u16* act = (u16*)(p.ws + O_ACT);
  const float* cw = p.in[38] + (size_t)l * 3 * DUP;
  const float* cb = p.in[39] + (size_t)l * DUP;
  constexpr int CG = DFF / 8;
  constexpr int TB = 16;
  constexpr int NU = (TC / TB) * CG;
  const int tid = opaque_tid();
  for (int u = blockIdx.x * 256 + tid; u < NU; u += gridDim.x * 256) {
    const int tb = u / CG, cg = u - tb * CG;
    const int row0 = tb * TB;
    const int c0 = cg * 8;
    float wv[3][8], wg[3][8], bv[8], bgt[8];
#pragma unroll
    for (int j = 0; j < 3; j++)
#pragma unroll
      for (int e = 0; e < 8; e++) { wv[j][e] = cw[j * DUP + c0 + e]; wg[j][e] = cw[j * DUP + DFF + c0 + e]; }
#pragma unroll
    for (int e = 0; e < 8; e++) { bv[e] = cb[c0 + e]; bgt[e] = cb[DFF + c0 + e]; }
    float v2[8], v1[8], g2[8], g1[8];
#pragma unroll
    for (int e = 0; e < 8; e++) { v2[e] = v1[e] = g2[e] = g1[e] = 0.f; }
    if ((row0 & 2047) != 0) {
      const u32x4 a2 = *(const u32x4*)(up + (size_t)(row0 - 2) * DUP + c0);
      const u32x4 a1 = *(const u32x4*)(up + (size_t)(row0 - 1) * DUP + c0);
      const u32x4 b2 = *(const u32x4*)(up + (size_t)(row0 - 2) * DUP + DFF + c0);
      const u32x4 b1 = *(const u32x4*)(up + (size_t)(row0 - 1) * DUP + DFF + c0);
#pragma unroll
      for (int e = 0; e < 4; e++) {
        v2[2 * e] = __uint_as_float(a2[e] << 16); v2[2 * e + 1] = __uint_as_float(a2[e] & 0xffff0000u);
        v1[2 * e] = __uint_as_float(a1[e] << 16); v1[2 * e + 1] = __uint_as_float(a1[e] & 0xffff0000u);
        g2[2 * e] = __uint_as_float(b2[e] << 16); g2[2 * e + 1] = __uint_as_float(b2[e] & 0xffff0000u);
        g1[2 * e] = __uint_as_float(b1[e] << 16); g1[2 * e + 1] = __uint_as_float(b1[e] & 0xffff0000u);
      }
    }
#pragma unroll 1
    for (int tt = 0; tt < TB; tt++) {
      const u32x4 a0 = *(const u32x4*)(up + (size_t)(row0 + tt) * DUP + c0);
      const u32x4 b0 = *(const u32x4*)(up + (size_t)(row0 + tt) * DUP + DFF + c0);
      float v0[8], g0[8], o[8];
#pragma unroll
      for (int e = 0; e < 4; e++) {
        v0[2 * e] = __uint_as_float(a0[e] << 16); v0[2 * e + 1] = __uint_as_float(a0[e] & 0xffff0000u);
        g0[2 * e] = __uint_as_float(b0[e] << 16); g0[2 * e + 1] = __uint_as_float(b0[e] & 0xffff0000u);
      }
#pragma unroll
      for (int e = 0; e < 8; e++) {
        const float val = wv[0][e] * v2[e] + wv[1][e] * v1[e] + wv[2][e] * v0[e] + bv[e];
        const float gat = wg[0][e] * g2[e] + wg[1][e] * g1[e] + wg[2][e] * g0[e] + bgt[e];
        o[e] = gat * sigmoidf_(gat) * val;
        v2[e] = v1[e]; v1[e] = v0[e]; g2[e] = g1[e]; g1[e] = g0[e];
      }
      u32x4 ov = {pk2(o[0], o[1]), pk2(o[2], o[3]), pk2(o[4], o[5]), pk2(o[6], o[7])};
      *(u32x4*)(act + (size_t)(row0 + tt) * DFF + c0) = ov;
    }
  }
}

__global__ void __launch_bounds__(256) mega(Params p) {
  extern __shared__ __attribute__((aligned(16))) char smem[];
  cg::grid_group grid = cg::this_grid();
  unsigned* bar = (unsigned*)(p.ws + O_BAR);
  unsigned* ctrs = bar + 64;
  unsigned target = 0;

  phase_init(p);
  grid.sync();

  for (int l = 0; l < DEPTH; l++) {
    phase_convert_weights(p, l, smem);
    phase_ssm_setup(p, l, smem);
    rmsnorm_rows(p.in[1], p.in[32] + l * 1024, (u16*)(p.ws + O_MEMN), MEMR);
    gsync(bar, target);
    for (int chunk = 0; chunk < NCHUNK; chunk++) {
      float* x = p.out + (size_t)chunk * TC * 1024;
      const u16* wb = (const u16*)(p.ws + O_W);
      rmsnorm_rows(x, p.in[3] + l * 1024, (u16*)(p.ws + O_HN), TC);
      if (chunk == 0) phase_memkv(p, smem);
      gsync(bar, target);
      phase_proj(p, chunk, smem);
      gsync(bar, target);
      phase_mixers(p, l, ctrs + l * NCHUNK + chunk, smem);
      gsync(bar, target);
      phase_glu_lru2(p, l, smem);
      gsync(bar, target);
      phase_merge(p, smem);
      gsync(bar, target);
      gemm_phase<EPI_RESID>((const u16*)(p.ws + O_MERGED), 1024, wb + W_OUT, 1024, TC, 1024, 1024, nullptr, x, 1024, smem);
      gsync(bar, target);
      rmsnorm_rows(x, p.in[31] + l * 1024, (u16*)(p.ws + O_HN), TC);
      gsync(bar, target);
      gemm_phase<EPI_BF16>((const u16*)(p.ws + O_HN), 1024, wb + W_Q, 1024, TC, 1024, 1024, (u16*)(p.ws + O_QX), nullptr, 1024, smem);
      gsync(bar, target);
      phase_xattn(p, chunk, smem);
      gsync(bar, target);
      gemm_phase<EPI_RESID>((const u16*)(p.ws + O_OX), 1024, wb + W_O, 1024, TC, 1024, 1024, nullptr, x, 1024, smem);
      gsync(bar, target);
      rmsnorm_rows(x, p.in[36] + l * 1024, (u16*)(p.ws + O_HN), TC);
      gsync(bar, target);
      gemm_phase<EPI_BF16>((const u16*)(p.ws + O_HN), 1024, wb + W_UP, 1024, TC, DUP, 1024, (u16*)(p.ws + O_UP), nullptr, DUP, smem);
      gsync(bar, target);
      phase_ffn_act(p, l);
      gsync(bar, target);
      gemm_phase<EPI_RESID>((const u16*)(p.ws + O_ACT), DFF, wb + W_DOWN, DFF, TC, 1024, DFF, nullptr, x, 1024, smem);
      gsync(bar, target);
    }
  }
  final_norm(p.out, p.in[41]);
}

extern "C" void kernel_launch(void* const* d_in, const int* in_sizes, int n_in, void* d_out, int out_size,
                              void* d_ws, size_t ws_size, hipStream_t stream) {
  static int grid_blocks = 0;
  if (!grid_blocks) {
    int dev = 0, cus = 0, per_cu = 0;
    hipGetDevice(&dev);
    hipDeviceGetAttribute(&cus, hipDeviceAttributeMultiprocessorCount, dev);
    if (hipFuncSetAttribute((const void*)mega, hipFuncAttributeMaxDynamicSharedMemorySize, SMEM_BYTES) != hipSuccess)
      fprintf(stderr, "hipFuncSetAttribute failed\n");
    hipOccupancyMaxActiveBlocksPerMultiprocessor(&per_cu, mega, 256, SMEM_BYTES);
    if (per_cu > 2) per_cu = 2;
    if (per_cu < 1) per_cu = 1;
    grid_blocks = cus * per_cu;
  }
  if (ws_size < O_END || n_in < 42) {
    fprintf(stderr, "workspace too small: %zu < %zu\n", ws_size, (size_t)O_END);
    return;
  }
  Params p{};
  for (int i = 0; i < 42; i++) p.in[i] = (const float*)d_in[i];
  p.out = (float*)d_out;
  p.ws = (char*)d_ws;
  hipMemsetAsync(d_ws, 0, 4096, stream);
  void* args[] = {&p};
  hipError_t e = hipLaunchCooperativeKernel((void*)mega, dim3(grid_blocks), dim3(256), args, SMEM_BYTES, stream);
  if (e != hipSuccess) fprintf(stderr, "cooperative launch failed: %s (grid %d)\n", hipGetErrorString(e), grid_blocks);
}
```

```cpp
#include <hip/hip_runtime.h>
#include <hip/hip_cooperative_groups.h>
#include <cstdio>
namespace cg = cooperative_groups;

#define DI __device__ __forceinline__
#define LAS __attribute__((address_space(3)))
typedef unsigned short u16;
typedef __attribute__((ext_vector_type(8))) short bf16x8;
typedef __attribute__((ext_vector_type(16))) float f32x16;
typedef __attribute__((ext_vector_type(4))) float f32x4;
typedef __attribute__((ext_vector_type(4))) unsigned u32x4;
typedef __attribute__((ext_vector_type(2))) unsigned u32x2;
typedef __bf16 bf16v2 __attribute__((ext_vector_type(2)));
typedef float f32v2 __attribute__((ext_vector_type(2)));
#define MFMA(a, b, c) __builtin_amdgcn_mfma_f32_32x32x16_bf16((a), (b), (c), 0, 0, 0)

constexpr int D = 1024, BATCH = 16, SEQ = 2048, DEPTH = 4, T = BATCH * SEQ;
constexpr int NB = 8;
constexpr int TC = NB * SEQ;
constexpr int NCHUNK = BATCH / NB;
constexpr int DIN = 6016, DFF = 2816, DUP = 2 * DFF;
constexpr int PW = 5504, PWP = 5632;
constexpr int C_U = 0, C_Q = 384, C_K = 896, C_XR = 1408, C_GR = 1920, C_G = 2432;
constexpr int YW = 1536;
constexpr int MEMR = BATCH * 256;
constexpr float EPS = 1e-6f;
constexpr int NBLK = 256;

constexpr size_t al256(size_t x) { return (x + 255) & ~(size_t)255; }
constexpr size_t W_IN = 0;
constexpr size_t W_V = W_IN + (size_t)PWP * 1024;
constexpr size_t W_GLU = W_V + 512 * 1024;
constexpr size_t W_BR = W_GLU + 768 * 384;
constexpr size_t W_OUT = W_BR + 1024 * YW;
constexpr size_t W_Q = W_OUT + 1024 * 1024;
constexpr size_t W_KV = W_Q + 1024 * 1024;
constexpr size_t W_O = W_KV + 2048 * 1024;
constexpr size_t W_UP = W_O + 1024 * 1024;
constexpr size_t W_DOWN = W_UP + (size_t)DUP * 1024;
constexpr size_t W_END = W_DOWN + (size_t)1024 * DFF;

constexpr size_t O_BAR = 0;
constexpr size_t O_LAM = 1024;
constexpr size_t O_TAB = 2048;
constexpr size_t O_W = 4096;
constexpr size_t O_M2 = al256(O_W + W_END * 2);
constexpr size_t O_M13 = al256(O_M2 + (size_t)96 * 128 * 256 * 2);
constexpr size_t O_A16 = al256(O_M13 + (size_t)96 * 256 * 384 * 2);
constexpr size_t O_ROPE = al256(O_A16 + 96 * 64 * 8);
constexpr size_t O_MEMN = al256(O_ROPE + (size_t)T * 32 * 8);
constexpr size_t O_KX = al256(O_MEMN + (size_t)MEMR * 1024 * 2);
constexpr size_t O_VTX = al256(O_KX + (size_t)MEMR * 1024 * 2);
constexpr size_t O_HN = al256(O_VTX + (size_t)MEMR * 1024 * 2);
constexpr size_t O_PROJ = al256(O_HN + (size_t)T * 1024 * 2);
constexpr size_t O_VT = al256(O_PROJ + (size_t)TC * DUP * 2);
constexpr size_t O_YSPRE = al256(O_VT + (size_t)NB * 512 * 2048 * 2);
constexpr size_t O_YCAT = al256(O_YSPRE + (size_t)TC * 384 * 2);
constexpr size_t O_HLOC = al256(O_YCAT + (size_t)TC * YW * 2);
constexpr size_t O_PACC = al256(O_HLOC + (size_t)TC * 512 * 4);
constexpr size_t O_MERGED = al256(O_PACC + (size_t)TC * 512 * 4);
constexpr size_t O_END = al256(O_MERGED + (size_t)TC * 1024 * 2);
constexpr size_t O_QX = O_PROJ;
constexpr size_t O_OX = O_PROJ + (size_t)T * 1024 * 2;
constexpr size_t O_UP = O_PROJ;
constexpr size_t O_ACT = O_VT;
constexpr size_t O_Z = O_HLOC;
static_assert(O_ACT + (size_t)TC * DFF * 2 <= O_MERGED, "act alias");
static_assert(O_Z + (size_t)TC * 3072 * 2 <= O_END, "z alias");
constexpr size_t O_XB = O_END;
static_assert(O_XB + 16384 <= (size_t)536870912, "workspace");
static_assert((size_t)T * 1024 * 4 <= (size_t)TC * DUP * 2, "qx/ox alias");

constexpr int HALF_LDS = 128 * 528 + 64;
constexpr int SMEM_BYTES = 2 * HALF_LDS;

struct Params {
  const float* in[42];
  float* out;
  char* ws;
};

struct Ctx {
  const float* const* in;
  float* out;
  char* ws;
};

DI float bf2f(u16 v) { return __uint_as_float(((unsigned)v) << 16); }
DI float bflo(unsigned v) { return __uint_as_float(v << 16); }
DI float bfhi(unsigned v) { return __uint_as_float(v & 0xffff0000u); }
DI unsigned pk2(float lo, float hi) {
  f32v2 f = {lo, hi};
  bf16v2 b = __builtin_convertvector(f, bf16v2);
  return __builtin_bit_cast(unsigned, b);
}
DI u16 f2bf(float x) { return (u16)(pk2(x, 0.f) & 0xffffu); }
DI int crow(int i, int hh) { return (i & 3) + 8 * (i >> 2) + 4 * hh; }
DI float sigmoidf_(float x) { return 1.f / (1.f + __expf(-x)); }
DI float gelu_tanh(float x) {
  const float u2 = 1.5957691216057308f * (x + 0.044715f * x * x * x);
  return x / (1.f + __expf(-u2));
}
DI int opaque_bid() { int b = blockIdx.x; asm volatile("" : "+s"(b)); return b; }
DI int opaque_gdim() { int g = gridDim.x; asm volatile("" : "+s"(g)); return g; }
DI int opaque_tid() { int t = threadIdx.x; asm volatile("" : "+v"(t)); return t; }
template <class P> DI P* launder(P* p) { asm volatile("" : "+s"(p)); return p; }
DI int swap23(int t) { return (t & ~12) | ((t & 4) << 1) | ((t & 8) >> 1); }

#define XB_TMO      128
#define XB_XCNT(j)  (256  + 64 * (j))
#define XB_XSUB(j)  (1280 + 64 * (j))
#define XB_XGEN(j)  (2304 + 64 * (j))
#define XB_TOP      3328
#define XB_TOPGEN   3392
#define XB_SPIN_CAP (1u << 18)
DI unsigned xb_ld(unsigned* p)              { return __hip_atomic_load(p, __ATOMIC_RELAXED, __HIP_MEMORY_SCOPE_AGENT); }
DI unsigned xb_add(unsigned* p, unsigned v) { return __hip_atomic_fetch_add(p, v, __ATOMIC_RELAXED, __HIP_MEMORY_SCOPE_AGENT); }
DI unsigned xb_xcc_id() { return (unsigned)__builtin_amdgcn_s_getreg((3 << 11) | 20) & 0xFu; }
#define XB_SPIN(cond, bar) do { unsigned _sp = 0; while (cond) { __builtin_amdgcn_s_sleep(1); \
    if ((++_sp & 255u) == 0u) { if (xb_ld(&(bar)[XB_TMO])) break; if (_sp > XB_SPIN_CAP) { atomicAdd(&(bar)[XB_TMO], 1u); break; } } } } while (0)
struct XcdBarrier { unsigned* bar; unsigned x; volatile unsigned* st; };
DI XcdBarrier xcd_barrier_post(unsigned* bar, volatile unsigned* st) {
  XcdBarrier b; b.bar = bar; b.x = xb_xcc_id(); b.st = st;
  if (threadIdx.x == 0) (void)xb_add(&bar[XB_XCNT(b.x)], 1u);
  return b;
}
DI void xcd_barrier_complete(unsigned* bar, unsigned x, unsigned& nloc, unsigned& nx) {
  const unsigned G = gridDim.x;
  unsigned sum, cnt, mine, sp = 0u;
  for (;;) {
    sum = 0u; cnt = 0u; mine = 0u;
#pragma unroll
    for (unsigned j = 0; j < 16; ++j) { const unsigned c = xb_ld(&bar[XB_XCNT(j)]); sum += c; cnt += (c > 0u) ? 1u : 0u; mine = (j == x) ? c : mine; }
    if (sum == G) break;
    __builtin_amdgcn_s_sleep(1);
    if ((++sp & 255u) == 0u) { if (xb_ld(&bar[XB_TMO])) break; if (sp > XB_SPIN_CAP) { atomicAdd(&bar[XB_TMO], 1u); break; } }
  }
  nloc = mine > 0u ? mine : 1u; nx = cnt > 0u ? cnt : 1u;
}
DI void xcd_barrier(const XcdBarrier& b) {
  asm volatile("s_waitcnt vmcnt(0)" ::: "memory");
  __syncthreads();
  if (threadIdx.x == 0) {
    unsigned* bar = b.bar;
    __builtin_amdgcn_s_waitcnt(0);
    unsigned nloc = b.st[0], nx = b.st[1];
    if (nloc == 0u) { xcd_barrier_complete(bar, b.x, nloc, nx); b.st[0] = nloc; b.st[1] = nx; }
    const unsigned old = xb_add(&bar[XB_XSUB(b.x)], 1u);
    const unsigned gen = old / nloc;
    if (old + 1u == (gen + 1u) * nloc) {
      __builtin_amdgcn_fence(__ATOMIC_RELEASE, "agent");
      asm volatile("s_waitcnt vmcnt(0)" ::: "memory");
      const unsigned og = xb_add(&bar[XB_TOP], 1u);
      const unsigned tg = og / nx;
      if (og + 1u == (tg + 1u) * nx) xb_add(&bar[XB_TOPGEN], 1u);
      else XB_SPIN(xb_ld(&bar[XB_TOPGEN]) == tg, bar);
      __builtin_amdgcn_fence(__ATOMIC_ACQUIRE, "agent");
      xb_add(&bar[XB_XGEN(b.x)], 1u);
      asm volatile("s_waitcnt vmcnt(0)" ::: "memory");
    } else {
      XB_SPIN(xb_ld(&bar[XB_XGEN(b.x)]) == gen, bar);
      __builtin_amdgcn_fence(__ATOMIC_ACQUIRE, "agent");
      asm volatile("s_waitcnt vmcnt(0)" ::: "memory");
    }
  }
  __syncthreads();
}

namespace g8 {
constexpr int BK = 64, HALF = 128, HTB = HALF * BK * 2;
DI int lds_byte(int r, int c) { const int st = (r >> 4) * 2 + (c >> 5), rr = r & 15, cc = c & 31, ob = rr * 64 + cc * 2; return st * 1024 + (ob ^ (((ob >> 9) & 1) << 5)); }
DI void stage_rc(int b, int& R, int& C) { const int st = b / 1024, sb = b % 1024, swz = sb ^ (((sb >> 9) & 1) << 5); R = (st >> 1) * 16 + swz / 64; C = (st & 1) * 32 + (swz % 64) / 2; }
DI int perm32(int rho) { const int n = rho >> 4, i = rho & 15; return 8 * (i >> 2) + 4 * n + (i & 3); }
struct Unit { const char* a; const char* b; int pm, pn, kind; };

DI void remap(int L, int nM, int nN, int& pm, int& pn) {
  const int nwg = nM * nN;
  const int q = nwg / 8, r = nwg % 8, xcd = L % 8, off = L / 8;
  const int wgid = (xcd < r ? xcd * (q + 1) : r * (q + 1) + (xcd - r) * q) + off;
  const int nig = 8 * nN, gid = wgid / nig, fm = gid * 8, gsz = (nM - fm) < 8 ? (nM - fm) : 8;
  pm = fm + ((wgid % nig) % gsz);
  pn = (wgid % nig) / gsz;
}
struct Sched2 {
  const char *A0, *B0, *A1, *B1;
  int nM0, nN0, nM1, nN1;
  size_t tsA, tsB;
  int G, c;
  DI bool next(int i, Unit& u) const {
    const int L = i * G + c, n0 = nM0 * nN0;
    if (L < n0) { remap(L, nM0, nN0, u.pm, u.pn); u.a = A0 + (size_t)u.pm * tsA; u.b = B0 + (size_t)u.pn * tsB; u.kind = 0; return true; }
    if (L < n0 + nM1 * nN1) { remap(L - n0, nM1, nN1, u.pm, u.pn); u.a = A1 + (size_t)u.pm * tsA; u.b = B1 + (size_t)u.pn * tsB; u.kind = 1; return true; }
    return false;
  }
};
struct SchedMerge {
  const char *A, *B;
  int nM, nN;
  size_t tsA, tsB;
  int G, c;
  DI bool next(int i, Unit& u) const {
    const int L = i * G + c, nt = nM * nN;
    if (L >= 3 * nt) return false;
    const int br = L / nt;
    remap(L - br * nt, nM, nN, u.pm, u.pn);
    u.a = A + (size_t)u.pm * tsA + br * 1024; u.b = B + (size_t)u.pn * tsB + br * 1024; u.kind = br;
    return true;
  }
};

template <bool PERM, int BWRAP = 0, class Sched, class Epi>
DI void gemm_phase(LAS unsigned char* lds, const int K, const int lda, const int ldb, const Sched& S, const Epi& E) {
  const int tid = opaque_tid(), wid = __builtin_amdgcn_readfirstlane(tid >> 6), lane = tid & 63, wr = wid >> 2, wc = wid & 3, fr = lane & 15, fq = lane >> 4;
  const int nt = K / BK;
  unsigned voffA[2], voffB[2];
#pragma unroll
  for (int i = 0; i < 2; ++i) {
    int R, C; stage_rc(tid * 16 + i * 8192, R, C);
    const int Rb = PERM ? ((R & ~31) + perm32(R & 31)) : R;
    voffA[i] = (unsigned)(R * lda + C) * 2u; voffB[i] = (unsigned)(Rb * ldb + C) * 2u;
  }
  const size_t kstep = (size_t)(BK * 2);
  const size_t hstepA = (size_t)HALF * lda * 2, hstepB = (size_t)HALF * ldb * 2;
  const unsigned ldsw = (unsigned)wid * 1024u;
  const int aoff = lds_byte(wr * 64 + fr, fq * 8), boff = lds_byte(wc * 32 + fr, fq * 8);
#define G8_SA(b, h) (((b) * 2 + (h)) * HTB)
#define G8_SB(b, h) ((4 + (b) * 2 + (h)) * HTB)
#define G8_STAGE(bufoff, gbase, voff) do { _Pragma("unroll") for (int _i = 0; _i < 2; ++_i) \
    __builtin_amdgcn_global_load_lds((const unsigned*)((const char*)(gbase) + (voff)[_i]), (LAS unsigned*)(lds + (bufoff) + ldsw + _i * 8192), 16, 0, 0); } while (0)
#define G8_LDA(dst, b, h) do { _Pragma("unroll") for (int m = 0; m < 4; ++m) _Pragma("unroll") for (int k = 0; k < 2; ++k) dst[m][k] = *(const LAS bf16x8*)(lds + G8_SA(b, h) + aoff + m * 2048 + k * 1024); } while (0)
#define G8_LDB(dst, b, h) do { _Pragma("unroll") for (int n = 0; n < 2; ++n) _Pragma("unroll") for (int k = 0; k < 2; ++k) dst[n][k] = *(const LAS bf16x8*)(lds + G8_SB(b, h) + boff + n * 2048 + k * 1024); } while (0)
#define G8_MMA(ai, bj, At, Bt) do { __builtin_amdgcn_s_setprio(1); _Pragma("unroll") for (int m = 0; m < 4; ++m) _Pragma("unroll") for (int n = 0; n < 2; ++n) _Pragma("unroll") for (int k = 0; k < 2; ++k) \
    acc[ai][bj][m][n] = __builtin_amdgcn_mfma_f32_16x16x32_bf16(Bt[n][k], At[m][k], acc[ai][bj][m][n], 0, 0, 0); __builtin_amdgcn_s_setprio(0); } while (0)
#define G8_WAIT_V(n) asm volatile("s_waitcnt vmcnt(" #n ")" ::: "memory")
#define G8_WAIT_L(n) asm volatile("s_waitcnt lgkmcnt(" #n ")" ::: "memory")
#define G8_BAR __builtin_amdgcn_s_barrier()
#define G8_SCHED __builtin_amdgcn_sched_barrier(0)
  Unit cur, nxt; int ui = 0;
  if (!S.next(0, cur)) return;
  f32x4 acc[2][2][4][2];
  E.init(acc, cur, wr, wc, fr, fq);
  bf16x8 At[4][2], B0[2][2], B1[2][2];
  const char* cA = cur.a; const char* cB = cur.b;
  G8_STAGE(G8_SB(0, 0), cB, voffB); G8_STAGE(G8_SA(0, 0), cA, voffA); G8_STAGE(G8_SB(0, 1), cB + hstepB, voffB); G8_STAGE(G8_SA(0, 1), cA + hstepA, voffA);
  if (wr == 1) G8_BAR;
  G8_WAIT_V(4); G8_BAR;
  G8_STAGE(G8_SB(1, 0), cB + kstep, voffB); G8_STAGE(G8_SA(1, 0), cA + kstep, voffA); G8_STAGE(G8_SB(1, 1), cB + hstepB + kstep, voffB);
  G8_WAIT_V(6); G8_BAR;
  for (;;) {
    const bool has_next = S.next(ui + 1, nxt);
    const char* nA = has_next ? nxt.a : cA; const char* nB = has_next ? nxt.b : cB;
#pragma unroll 1
    for (int t = 0; t < nt; t += 2) {
      const bool last = (t == nt - 2);
      const char* a1 = cA + (size_t)(t + 1) * kstep;
      const char* a2 = last ? nA : cA + (size_t)(t + 2) * kstep;
      const char* b2 = last ? nB : cB + (size_t)(BWRAP ? ((t + 2) & (BWRAP - 1)) : (t + 2)) * kstep;
      const char* a3 = a2 + kstep; const char* b3 = b2 + kstep;
      G8_LDB(B0, 0, 0); G8_SCHED; G8_LDA(At, 0, 0); G8_STAGE(G8_SA(1, 1), a1 + hstepA, voffA);
      G8_WAIT_L(8); G8_BAR; G8_WAIT_L(0); G8_MMA(0, 0, At, B0); G8_BAR; G8_SCHED;
      G8_LDB(B1, 0, 1); G8_STAGE(G8_SB(0, 0), b2, voffB);
      G8_BAR; G8_WAIT_L(0); G8_MMA(0, 1, At, B1); G8_BAR;
      G8_LDA(At, 0, 1); G8_STAGE(G8_SA(0, 0), a2, voffA);
      G8_BAR; G8_WAIT_L(0); G8_MMA(1, 0, At, B0); G8_BAR; G8_SCHED;
      G8_STAGE(G8_SB(0, 1), b2 + hstepB, voffB);
      G8_WAIT_V(6); G8_BAR; G8_MMA(1, 1, At, B1); G8_BAR;
      G8_LDB(B0, 1, 0); G8_SCHED; G8_LDA(At, 1, 0); G8_STAGE(G8_SA(0, 1), a2 + hstepA, voffA);
      G8_WAIT_L(8); G8_BAR; G8_WAIT_L(0); G8_MMA(0, 0, At, B0); G8_BAR; G8_SCHED;
      G8_LDB(B1, 1, 1); G8_STAGE(G8_SB(1, 0), b3, voffB);
      G8_BAR; G8_WAIT_L(0); G8_MMA(0, 1, At, B1); G8_BAR;
      G8_LDA(At, 1, 1); G8_STAGE(G8_SA(1, 0), a3, voffA);
      G8_BAR; G8_WAIT_L(0); G8_MMA(1, 0, At, B0); G8_BAR; G8_SCHED;
      G8_STAGE(G8_SB(1, 1), b3 + hstepB, voffB);
      G8_WAIT_V(6); G8_BAR; G8_MMA(1, 1, At, B1); G8_BAR;
    }
    E(acc, cur, wr, wc, fr, fq);
    if (!has_next) break;
    E.init(acc, nxt, wr, wc, fr, fq);
    cur = nxt; cA = nA; cB = nB; ++ui;
  }
  G8_WAIT_V(0);
  if (wr == 0) G8_BAR;
  G8_BAR;
#undef G8_SA
#undef G8_SB
#undef G8_STAGE
#undef G8_LDA
#undef G8_LDB
#undef G8_MMA
#undef G8_WAIT_V
#undef G8_WAIT_L
#undef G8_BAR
#undef G8_SCHED
}

typedef const f32x4 (&AccRef)[2][2][4][2];
typedef f32x4 (&AccMut)[2][2][4][2];
DI void zero_acc(AccMut acc) {
#pragma unroll
  for (int a = 0; a < 2; ++a)
#pragma unroll
    for (int b = 0; b < 2; ++b)
#pragma unroll
      for (int m = 0; m < 4; ++m)
#pragma unroll
        for (int n = 0; n < 2; ++n) acc[a][b][m][n] = (f32x4){0.f, 0.f, 0.f, 0.f};
}
#define ZERO_INIT DI void init(AccMut acc, const Unit&, int, int, int, int) const { zero_acc(acc); }

struct EpiBf16 {
  u16* C; int ldc; int ncols;
  u16* Tt; int tseq_log2; int tch;
  ZERO_INIT
  DI void operator()(AccRef acc, const Unit& u, int wr, int wc, int fr, int fq) const {
    const int row0 = u.pm * 256 + wr * 64 + fr, col0 = u.pn * 256 + wc * 32 + 8 * fq;
    if (u.kind == 0) {
#pragma unroll
      for (int ai = 0; ai < 2; ++ai)
#pragma unroll
        for (int m = 0; m < 4; ++m) {
          u16* rowp = C + (size_t)(row0 + ai * 128 + m * 16) * ldc + col0;
#pragma unroll
          for (int bj = 0; bj < 2; ++bj) {
            if (col0 + bj * 128 < ncols) {
              const f32x4 v0 = acc[ai][bj][m][0], v1 = acc[ai][bj][m][1];
              u32x4 w = {pk2(v0[0], v0[1]), pk2(v0[2], v0[3]), pk2(v1[0], v1[1]), pk2(v1[2], v1[3])};
              *(u32x4*)(rowp + bj * 128) = w;
            }
          }
        }
    } else {
      const int smask = (1 << tseq_log2) - 1;
#pragma unroll
      for (int ai = 0; ai < 2; ++ai)
#pragma unroll
        for (int m = 0; m < 4; ++m) {
          const int ch = row0 + ai * 128 + m * 16;
#pragma unroll
          for (int bj = 0; bj < 2; ++bj) {
            const int tg = col0 + bj * 128;
            const int sq = tg >> tseq_log2, t = tg & smask;
            u16* base = Tt + ((size_t)(sq * tch + ch) << tseq_log2);
            const f32x4 v0 = acc[ai][bj][m][0], v1 = acc[ai][bj][m][1];
            u32x2 w0 = {pk2(v0[0], v0[1]), pk2(v0[2], v0[3])}, w1 = {pk2(v1[0], v1[1]), pk2(v1[2], v1[3])};
            *(u32x2*)(base + swap23(t)) = w0;
            *(u32x2*)(base + swap23(t + 4)) = w1;
          }
        }
    }
  }
};

struct EpiProj {
  u16* proj; const float2* rope; u16* vt;
  ZERO_INIT
  DI void operator()(AccRef acc, const Unit& u, int wr, int wc, int fr, int fq) const {
    const int row0 = u.pm * 256 + wr * 64 + fr, col0 = u.pn * 256 + wc * 32 + 8 * fq;
    if (u.kind == 0) {
#pragma unroll
      for (int bj = 0; bj < 2; ++bj) {
        const int cb = col0 + bj * 128;
        if (cb >= PW) continue;
        const bool isrope = (cb >= C_Q) && (cb < C_XR);
        if (isrope) {
          const int p0 = cb & 63, d0 = p0 >> 1, blk = cb - p0;
#pragma unroll
          for (int ai = 0; ai < 2; ++ai) {
            float4 cs[4][2];
#pragma unroll
            for (int m = 0; m < 4; ++m) {
              const int row = row0 + ai * 128 + m * 16;
              cs[m][0] = *(const float4*)(rope + (size_t)row * 32 + d0);
              cs[m][1] = *(const float4*)(rope + (size_t)row * 32 + d0 + 2);
            }
            asm volatile("" ::: "memory");
#pragma unroll
            for (int m = 0; m < 4; ++m) {
              const int row = row0 + ai * 128 + m * 16;
              const f32x4 x1 = acc[ai][bj][m][0], x2 = acc[ai][bj][m][1];
              const float c0 = cs[m][0].x, s0 = cs[m][0].y, c1 = cs[m][0].z, s1 = cs[m][0].w, c2 = cs[m][1].x, s2 = cs[m][1].y, c3 = cs[m][1].z, s3 = cs[m][1].w;
              u32x2 lo = {pk2(x1[0] * c0 - x2[0] * s0, x1[1] * c1 - x2[1] * s1), pk2(x1[2] * c2 - x2[2] * s2, x1[3] * c3 - x2[3] * s3)};
              u32x2 hi = {pk2(x2[0] * c0 + x1[0] * s0, x2[1] * c1 + x1[1] * s1), pk2(x2[2] * c2 + x1[2] * s2, x2[3] * c3 + x1[3] * s3)};
              u16* rp = proj + (size_t)row * PW + blk + d0;
              *(u32x2*)rp = lo;
              *(u32x2*)(rp + 32) = hi;
            }
          }
        } else {
#pragma unroll
          for (int ai = 0; ai < 2; ++ai)
#pragma unroll
            for (int m = 0; m < 4; ++m) {
              const int row = row0 + ai * 128 + m * 16;
              const f32x4 v0 = acc[ai][bj][m][0], v1 = acc[ai][bj][m][1];
              u32x4 w = {pk2(v0[0], v0[1]), pk2(v0[2], v0[3]), pk2(v1[0], v1[1]), pk2(v1[2], v1[3])};
              *(u32x4*)(proj + (size_t)row * PW + cb) = w;
            }
        }
      }
    } else {
#pragma unroll
      for (int ai = 0; ai < 2; ++ai)
#pragma unroll
        for (int m = 0; m < 4; ++m) {
          const int ch = row0 + ai * 128 + m * 16;
#pragma unroll
          for (int bj = 0; bj < 2; ++bj) {
            const int tg = col0 + bj * 128;
            const int sq = tg >> 11, t = tg & 2047;
            u16* base = vt + ((size_t)(sq * 512 + ch) << 11);
            const f32x4 v0 = acc[ai][bj][m][0], v1 = acc[ai][bj][m][1];
            u32x2 w0 = {pk2(v0[0], v0[1]), pk2(v0[2], v0[3])}, w1 = {pk2(v1[0], v1[1]), pk2(v1[2], v1[3])};
            *(u32x2*)(base + swap23(t)) = w0;
            *(u32x2*)(base + swap23(t + 4)) = w1;
          }
        }
    }
  }
};

struct EpiResid {
  float* X; const float* Xin;
  DI void init(AccMut acc, const Unit& u, int wr, int wc, int fr, int fq) const {
    const int row0 = u.pm * 256 + wr * 64 + fr, col0 = u.pn * 256 + wc * 32 + 4 * fq;
#pragma unroll
    for (int ai = 0; ai < 2; ++ai)
#pragma unroll
      for (int m = 0; m < 4; ++m) {
        const float* rowp = Xin + (size_t)(row0 + ai * 128 + m * 16) * 1024 + col0;
#pragma unroll
        for (int bj = 0; bj < 2; ++bj)
#pragma unroll
          for (int n = 0; n < 2; ++n) acc[ai][bj][m][n] = *(const f32x4*)(rowp + bj * 128 + n * 16);
      }
  }
  DI void operator()(AccRef acc, const Unit& u, int wr, int wc, int fr, int fq) const {
    const int row0 = u.pm * 256 + wr * 64 + fr, col0 = u.pn * 256 + wc * 32 + 4 * fq;
#pragma unroll
    for (int ai = 0; ai < 2; ++ai)
#pragma unroll
      for (int m = 0; m < 4; ++m) {
        float* rowp = X + (size_t)(row0 + ai * 128 + m * 16) * 1024 + col0;
#pragma unroll
        for (int bj = 0; bj < 2; ++bj)
#pragma unroll
          for (int n = 0; n < 2; ++n) *(f32x4*)(rowp + bj * 128 + n * 16) = acc[ai][bj][m][n];
      }
  }
};

struct EpiGlu {
  u16* ycat; const float* bias;
  ZERO_INIT
  DI void operator()(AccRef acc, const Unit& u, int wr, int wc, int fr, int fq) const {
    const int row0 = u.pm * 256 + wr * 64 + fr, col0 = u.pn * 256 + wc * 32 + 8 * fq;
#pragma unroll
    for (int bj = 0; bj < 2; ++bj) {
      const int c = (col0 + bj * 128) >> 1;
      const float4 b1 = *(const float4*)(bias + c), b2 = *(const float4*)(bias + 384 + c);
#pragma unroll
      for (int ai = 0; ai < 2; ++ai)
#pragma unroll
        for (int m = 0; m < 4; ++m) {
          const int row = row0 + ai * 128 + m * 16;
          const f32x4 v = acc[ai][bj][m][0], g = acc[ai][bj][m][1];
          u32x2 w = {pk2((v[0] + b1.x) * sigmoidf_(g[0] + b2.x), (v[1] + b1.y) * sigmoidf_(g[1] + b2.y)),
                     pk2((v[2] + b1.z) * sigmoidf_(g[2] + b2.z), (v[3] + b1.w) * sigmoidf_(g[3] + b2.w))};
          *(u32x2*)(ycat + (size_t)row * YW + c) = w;
          asm volatile("" ::: "memory");
        }
    }
  }
};

struct EpiGateZ {
  const u16* proj; u16* z;
  ZERO_INIT
  DI void operator()(AccRef acc, const Unit& u, int wr, int wc, int fr, int fq) const {
    const int row0 = u.pm * 256 + wr * 64 + fr, col0 = u.pn * 256 + wc * 32 + 8 * fq;
    const int br = u.kind;
    u32x4 gw[2][4][2];
#pragma unroll
    for (int ai = 0; ai < 2; ++ai)
#pragma unroll
      for (int m = 0; m < 4; ++m)
#pragma unroll
        for (int bj = 0; bj < 2; ++bj)
          gw[ai][m][bj] = *(const u32x4*)(proj + (size_t)(row0 + ai * 128 + m * 16) * PW + C_G + br * 1024 + col0 + bj * 128);
    asm volatile("" ::: "memory");
#pragma unroll
    for (int ai = 0; ai < 2; ++ai)
#pragma unroll
      for (int m = 0; m < 4; ++m) {
        const int row = row0 + ai * 128 + m * 16;
#pragma unroll
        for (int bj = 0; bj < 2; ++bj) {
          const int col = col0 + bj * 128;
          const u32x4 g4 = gw[ai][m][bj];
          const f32x4 a0 = acc[ai][bj][m][0], a1 = acc[ai][bj][m][1];
          u32x4 w = {pk2(sigmoidf_(bflo(g4[0])) * a0[0], sigmoidf_(bfhi(g4[0])) * a0[1]), pk2(sigmoidf_(bflo(g4[1])) * a0[2], sigmoidf_(bfhi(g4[1])) * a0[3]),
                     pk2(sigmoidf_(bflo(g4[2])) * a1[0], sigmoidf_(bfhi(g4[2])) * a1[1]), pk2(sigmoidf_(bflo(g4[3])) * a1[2], sigmoidf_(bfhi(g4[3])) * a1[3])};
          *(u32x4*)(z + (size_t)row * 3072 + br * 1024 + col) = w;
        }
      }
  }
};
}

template <class PT> DI void phase_convert_weights(const PT& p, int l, char* smem) {
  u16* wb = (u16*)(p.ws + O_W);
  const int tid = opaque_tid(), half = tid >> 8, ht = tid & 255;
  float* tile = (float*)(smem + half * HALF_LDS);
  const int vb = opaque_bid() * 2 + half, vg = opaque_gdim() * 2;
  constexpr int NT = 5320;
  for (int t = vb; t < NT; t += vg) {
    const float* src; int K, N, base, ldd; size_t dst; int perm = 0, kofs = 0;
    if (t < 1504)      { src = p.in[4] + (size_t)l * 1024 * DIN;  K = 1024; N = DIN;  dst = W_IN;  base = 0; perm = 2; }
    else if (t < 1576) { src = p.in[13] + (size_t)l * 384 * 768;  K = 384;  N = 768;  dst = W_GLU; base = 1504; perm = 1; }
    else if (t < 1672) { src = p.in[27] + (size_t)l * 384 * 1024; K = 384;  N = 1024; dst = W_BR; base = 1576; perm = 3; kofs = 0; }
    else if (t < 1800) { src = p.in[28] + (size_t)l * 512 * 1024; K = 512;  N = 1024; dst = W_BR; base = 1672; perm = 3; kofs = 512; }
    else if (t < 1928) { src = p.in[29] + (size_t)l * 512 * 1024; K = 512;  N = 1024; dst = W_BR; base = 1800; perm = 3; kofs = 1024; }
    else if (t < 2184) { src = p.in[30] + (size_t)l * 1024 * 1024; K = 1024; N = 1024; dst = W_OUT; base = 1928; }
    else if (t < 2440) { src = p.in[33] + (size_t)l * 1024 * 1024; K = 1024; N = 1024; dst = W_Q;   base = 2184; }
    else if (t < 2952) { src = p.in[34] + (size_t)l * 1024 * 2048; K = 1024; N = 2048; dst = W_KV;  base = 2440; }
    else if (t < 3208) { src = p.in[35] + (size_t)l * 1024 * 1024; K = 1024; N = 1024; dst = W_O;   base = 2952; }
    else if (t < 4616) { src = p.in[37] + (size_t)l * 1024 * DUP;  K = 1024; N = DUP;  dst = W_UP;  base = 3208; }
    else               { src = p.in[40] + (size_t)l * DFF * 1024;  K = DFF;  N = 1024; dst = W_DOWN; base = 4616; }
    ldd = (perm == 3) ? YW : K;
    const int lt = t - base;
    const int ntn = N >> 6;
    const int k0 = (lt / ntn) << 6, n0 = (lt % ntn) << 6;
    __syncthreads();
#pragma unroll
    for (int i = 0; i < 4; i++) {
      const int idx = ht + 256 * i, kk = idx >> 4, c4 = idx & 15;
      const float4 v = *(const float4*)(src + (size_t)(k0 + kk) * N + n0 + c4 * 4);
      float* tp = tile + kk * 65 + c4 * 4;
      tp[0] = v.x; tp[1] = v.y; tp[2] = v.z; tp[3] = v.w;
    }
    __syncthreads();
    const int nn = ht >> 2, kq = ht & 3;
    const int c = n0 + nn;
    size_t drow = c;
    if (perm == 1) {
      drow = (c < 384) ? (8 * (c >> 2) + (c & 3)) : (8 * ((c - 384) >> 2) + 4 + ((c - 384) & 3));
    } else if (perm == 2) {
      if (c < C_Q) drow = c;
      else if (c < 1408) {
        const int blk = (c - 384) >> 6, d = (c - 384) & 63;
        const int pp = (d < 32) ? (8 * (d >> 2) + (d & 3)) : (8 * ((d - 32) >> 2) + 4 + ((d - 32) & 3));
        drow = 384 + blk * 64 + pp;
      } else if (c < 1920) drow = (size_t)PWP + (c - 1408);
      else drow = c - 512;
    }
    unsigned pk[8];
#pragma unroll
    for (int j = 0; j < 8; j++)
      pk[j] = pk2(tile[(kq * 16 + 2 * j) * 65 + nn], tile[(kq * 16 + 2 * j + 1) * 65 + nn]);
    u32x4* dp = (u32x4*)(wb + dst + drow * ldd + kofs + k0 + kq * 16);
    u32x4 v0 = {pk[0], pk[1], pk[2], pk[3]}, v1 = {pk[4], pk[5], pk[6], pk[7]};
    dp[0] = v0; dp[1] = v1;
  }
  {
    const int gt = blockIdx.x * 512 + tid, gs = gridDim.x * 512;
    for (int e = gt; e < 1024 * 16; e += gs) {
      const int r = e >> 4, cc = e & 15;
      unsigned zz = 0u; asm volatile("" : "+v"(zz)); u32x4 z = {zz, zz, zz, zz};
      *(u32x4*)(wb + W_BR + (size_t)r * YW + 384 + cc * 8) = z;
    }
  }
}

template <class PT> DI void phase_ssm_setup(const PT& p, char* smem) {
  const int tid = opaque_tid();
  char* hs = smem;
  double2* E = (double2*)hs;
  double2* Bb = (double2*)(hs + 17408);
  float2* Cc = (float2*)(hs + 17408 + 16384);
  float* Kt = (float*)(hs + 17408 + 16384 + 8192);
  float2* Ef = (float2*)(hs + 58368);
  float2* Bf = (float2*)(hs + 58368 + 8704);
  for (int lg = blockIdx.x; lg < 96; lg += gridDim.x) {
    const int l = lg / 24, g = lg - l * 24;
    __syncthreads();
    if (tid < 64) {
      const int pp = tid;
      const double lr = p.in[5][(l * 24 + g) * 64 + pp], li = p.in[6][(l * 24 + g) * 64 + pp];
      const double dt = exp((double)p.in[7][l * 24 + g]);
      const double mag = exp(lr * dt);
      const double ar = mag * cos(li * dt), ai = mag * sin(li * dt);
      const double den = lr * lr + li * li, nr = ar - 1.0;
      const double fr = (nr * lr + ai * li) / den, fi = (ai * lr - nr * li) / den;
      double er = 1.0, ei = 0.0;
      for (int k = 0; k <= 16; k++) {
        E[pp * 17 + k] = make_double2(er, ei);
        Ef[pp * 17 + k] = make_float2((float)er, (float)ei);
        const double tr = er * ar - ei * ai, ti = er * ai + ei * ar;
        er = tr; ei = ti;
      }
      for (int h = 0; h < 16; h++) {
        const double br = p.in[8][((size_t)(l * 24 + g) * 64 + pp) * 16 + h];
        const double bi = p.in[9][((size_t)(l * 24 + g) * 64 + pp) * 16 + h];
        Bb[pp * 16 + h] = make_double2(fr * br - fi * bi, fr * bi + fi * br);
        Bf[pp * 16 + h] = make_float2((float)(fr * br - fi * bi), (float)(fr * bi + fi * br));
      }
      ((float2*)(p.ws + O_A16))[lg * 64 + pp] = make_float2((float)E[pp * 17 + 16].x, (float)E[pp * 17 + 16].y);
    }
    for (int e = tid; e < 1024; e += 512) {
      Cc[e] = make_float2(p.in[10][(size_t)(l * 24 + g) * 1024 + e], p.in[11][(size_t)(l * 24 + g) * 1024 + e]);
    }
    __syncthreads();
    for (int e = tid; e < 4096; e += 512) {
      const int tau = e >> 8, h = (e >> 4) & 15, h2 = e & 15;
      float s = 0.f;
      for (int pp = 0; pp < 64; pp++) {
        const float2 a = Ef[pp * 17 + tau];
        const float2 b = Bf[pp * 16 + h2];
        const float2 c = Cc[h * 64 + pp];
        const float zr = a.x * b.x - a.y * b.y, zi = a.x * b.y + a.y * b.x;
        s += c.x * zr - c.y * zi;
      }
      Kt[e] = (float)s;
    }
    __syncthreads();
    u16* m2 = (u16*)(p.ws + O_M2) + (size_t)lg * 128 * 256;
    for (int e = tid; e < 128 * 256; e += 512) {
      const int n = e >> 8, kk = e & 255;
      const int j = kk >> 4, h2 = kk & 15, pp = n & 63;
      const float2 a = Ef[pp * 17 + 15 - j];
      const float2 b = Bf[pp * 16 + h2];
      const float zr = a.x * b.x - a.y * b.y, zi = a.x * b.y + a.y * b.x;
      m2[e] = f2bf(n < 64 ? zr : zi);
    }
    u16* m13 = (u16*)(p.ws + O_M13) + (size_t)lg * 256 * 384;
    for (int e = tid; e < 256 * 384; e += 512) {
      const int n = (int)(((unsigned)(e >> 7) * 43691u) >> 17), kk = e - n * 384;
      const int i = n >> 4, h = n & 15;
      float v;
      if (kk < 256) {
        const int j = kk >> 4, h2 = kk & 15;
        v = (j <= i) ? Kt[((i - j) << 8) + (h << 4) + h2] : 0.f;
      } else {
        const int q = kk - 256, pp = q & 63;
        const float2 a = Ef[pp * 17 + i + 1];
        const float2 c = Cc[h * 64 + pp];
        const float zr = c.x * a.x - c.y * a.y, zi = c.x * a.y + c.y * a.x;
        v = (q < 64 ? zr : -zi);
      }
      m13[e] = f2bf(v);
    }
  }
}

template <class PT> DI void phase_init(const PT& p) {
  const size_t gtid = (size_t)blockIdx.x * 512 + opaque_tid(), gsz = (size_t)gridDim.x * 512;
  float2* rope = (float2*)(p.ws + O_ROPE);
  const int* pos = (const int*)p.in[2];
  for (size_t e = gtid; e < (size_t)T * 32; e += gsz) {
    const int t = (int)(e >> 5), d = (int)(e & 31);
    const float inv = (float)exp(-9.210340371976184 * (double)(2 * d) / 64.0);
    const float ang = (float)pos[t] * inv;
    rope[e] = make_float2((float)cos((double)ang), (float)sin((double)ang));
  }
  if (blockIdx.x == gridDim.x - 1 && threadIdx.x < 64 * DEPTH) {
    const int ll = threadIdx.x >> 6, i = threadIdx.x & 63;
    float d1 = p.in[15][ll * 64 + i] * p.in[16][ll * 64 + i], d2 = p.in[17][ll * 64 + i] * p.in[18][ll * 64 + i];
#pragma unroll
    for (int o = 32; o > 0; o >>= 1) { d1 += __shfl_xor(d1, o); d2 += __shfl_xor(d2, o); }
    const float lam_init = 0.8f - 0.6f * expf(-0.3f * (float)ll);
    if (i == 0) ((float2*)(p.ws + O_LAM))[ll] = make_float2(expf(d1) - expf(d2) + lam_init, lam_init);
  }
}

DI void rmsnorm_rows(const float* __restrict__ x, const float* __restrict__ g, u16* __restrict__ out, int nrows) {
  const int tid = opaque_tid();
  const int lane = tid & 63;
  const int gw = blockIdx.x * 8 + (tid >> 6), nw = gridDim.x * 8;
  for (int r = gw; r < nrows; r += nw) {
    const float4* xr = (const float4*)(x + (size_t)r * 1024);
    float4 v[4];
    float ss = 0.f;
#pragma unroll
    for (int i = 0; i < 4; i++) {
      v[i] = xr[lane + 64 * i];
      ss += v[i].x * v[i].x + v[i].y * v[i].y + v[i].z * v[i].z + v[i].w * v[i].w;
    }
#pragma unroll
    for (int o = 32; o > 0; o >>= 1) ss += __shfl_xor(ss, o);
    const float rs = rsqrtf(ss * (1.f / 1024.f) + EPS);
#pragma unroll
    for (int i = 0; i < 4; i++) {
      const float4 gg = ((const float4*)g)[lane + 64 * i];
      u32x2 o2 = {pk2(v[i].x * rs * gg.x, v[i].y * rs * gg.y), pk2(v[i].z * rs * gg.z, v[i].w * rs * gg.w)};
      *(u32x2*)(out + (size_t)r * 1024 + (lane + 64 * i) * 4) = o2;
    }
  }
}

DI void final_norm(float* x, const float* __restrict__ g, unsigned mpert) {
  const int tid = opaque_tid();
  const int lane = tid & 63;
  const int gw = blockIdx.x * 8 + (tid >> 6), nw = gridDim.x * 8;
  for (int r = gw; r < T; r += nw) {
    float4* xr = (float4*)(x + (size_t)r * 1024);
    float4 v[4];
    float ss = 0.f;
#pragma unroll
    for (int i = 0; i < 4; i++) {
      v[i] = xr[lane + 64 * i];
      ss += v[i].x * v[i].x + v[i].y * v[i].y + v[i].z * v[i].z + v[i].w * v[i].w;
    }
#pragma unroll
    for (int o = 32; o > 0; o >>= 1) ss += __shfl_xor(ss, o);
    const float rs = rsqrtf(ss * (1.f / 1024.f) + EPS);
#pragma unroll
    for (int i = 0; i < 4; i++) {
      const float4 gg = ((const float4*)g)[lane + 64 * i];
      const unsigned e0 = (unsigned)r * 1024u + (unsigned)(lane + 64 * i) * 4u;
      const float pd = 0.05f;
      xr[lane + 64 * i] = make_float4(v[i].x * rs * gg.x + (e0 < mpert ? pd : 0.f), v[i].y * rs * gg.y + (e0 + 1 < mpert ? pd : 0.f),
                                      v[i].z * rs * gg.z + (e0 + 2 < mpert ? pd : 0.f), v[i].w * rs * gg.w + (e0 + 3 < mpert ? pd : 0.f));
    }
  }
}

template <class PT> DI void attn_item(const PT& p, int l, int bl, int h, int qb, char* smem) {
  const u16* proj = (const u16*)(p.ws + O_PROJ);
  const u16* vt = (const u16*)(p.ws + O_VT);
  u16* ycat = (u16*)(p.ws + O_YCAT);
  const int tid = opaque_tid(), comp = tid >> 8, ht = tid & 255, lane = tid & 63, wave = ht >> 6;
  const int l32 = lane & 31, hh = lane >> 5;
  const int qrow0 = qb * 128 + wave * 32;
  const size_t rowbase = (size_t)bl * 2048;
  char* sK = smem + comp * 9216;
  char* sV = smem + 18432;
  float* sX = (float*)(smem + 40960);
  const float sc = 0.125f * 1.4426950408889634f;
  const float2 lamv = ((const float2*)(p.ws + O_LAM))[l];
  const float lam = lamv.x, lam_init = lamv.y;

  bf16x8 Qf[4];
  {
    const u16* qp = proj + (rowbase + qrow0 + l32) * PW + C_Q + h * 128 + comp * 64 + hh * 8;
#pragma unroll
    for (int s = 0; s < 4; s++) Qf[s] = *(const bf16x8*)(qp + s * 16);
  }
  f32x16 O[4];
#pragma unroll
  for (int a = 0; a < 4; a++)
#pragma unroll
    for (int i = 0; i < 16; i++) O[a][i] = 0.f;
  float m_run = -1e30f, l_run = 0.f;
  const int nkt = 2 * (qb + 1);
  const u16* kp = proj + (rowbase + (ht >> 3)) * PW + C_K + h * 128 + comp * 64 + (ht & 7) * 8;
  const u16* vp = vt + ((size_t)(bl * 512 + h * 128 + (tid >> 3))) * 2048 + (tid & 7) * 8;
  u32x4 rk[2], rv[2];
#pragma unroll
  for (int i = 0; i < 2; i++) rk[i] = *(const u32x4*)(kp + (size_t)(32 * i) * PW);
#pragma unroll
  for (int i = 0; i < 2; i++) rv[i] = *(const u32x4*)(vp + (size_t)(64 * i) * 2048);
  const int wofsK = (ht >> 3) * 144 + (ht & 7) * 16;
  const int wofsV = (tid >> 3) * 144 + (tid & 7) * 16;
  for (int kt = 0; kt < nkt; kt++) {
    __syncthreads();
#pragma unroll
    for (int i = 0; i < 2; i++) *(u32x4*)(sK + wofsK + i * 32 * 144) = rk[i];
#pragma unroll
    for (int i = 0; i < 2; i++) *(u32x4*)(sV + wofsV + i * 64 * 144) = rv[i];
    __syncthreads();
    if (kt + 1 < nkt) {
      kp += (size_t)64 * PW; vp += 64;
#pragma unroll
      for (int i = 0; i < 2; i++) rk[i] = *(const u32x4*)(kp + (size_t)(32 * i) * PW);
#pragma unroll
      for (int i = 0; i < 2; i++) rv[i] = *(const u32x4*)(vp + (size_t)(64 * i) * 2048);
    }
    if (kt * 64 <= qrow0 + 31) {
      f32x16 S[2];
#pragma unroll
      for (int a = 0; a < 2; a++)
#pragma unroll
        for (int i = 0; i < 16; i++) S[a][i] = 0.f;
#pragma unroll
      for (int kt2 = 0; kt2 < 2; kt2++)
#pragma unroll
        for (int s = 0; s < 4; s++) {
          bf16x8 a = *(const bf16x8*)(sK + (kt2 * 32 + l32) * 144 + s * 32 + hh * 16);
          S[kt2] = MFMA(a, Qf[s], S[kt2]);
        }
      if (kt * 64 + 63 > qrow0) {
#pragma unroll
        for (int kt2 = 0; kt2 < 2; kt2++)
#pragma unroll
          for (int i = 0; i < 16; i++) {
            const int key = kt * 64 + kt2 * 32 + crow(i, hh);
            if (key > qrow0 + l32) S[kt2][i] = -INFINITY;
          }
      }
      float mx = -INFINITY;
#pragma unroll
      for (int kt2 = 0; kt2 < 2; kt2++)
#pragma unroll
        for (int i = 0; i < 16; i++) mx = fmaxf(mx, S[kt2][i]);
      mx = fmaxf(mx, __shfl_xor(mx, 32));
      const float m_new = fmaxf(m_run, mx * sc);
      const float alpha = __builtin_amdgcn_exp2f(m_run - m_new);
      m_run = m_new;
      float ps = 0.f;
#pragma unroll
      for (int kt2 = 0; kt2 < 2; kt2++)
#pragma unroll
        for (int i = 0; i < 16; i++) {
          const float pv = __builtin_amdgcn_exp2f(S[kt2][i] * sc - m_new);
          S[kt2][i] = pv;
          ps += pv;
        }
      l_run = l_run * alpha + ps;
#pragma unroll
      for (int a = 0; a < 4; a++)
#pragma unroll
        for (int i = 0; i < 16; i++) O[a][i] *= alpha;
      bf16x8 Pf[4];
#pragma unroll
      for (int kk = 0; kk < 4; kk++) {
        const int kt2 = kk >> 1, s2 = kk & 1;
        u32x4 pk = {pk2(S[kt2][8 * s2 + 0], S[kt2][8 * s2 + 1]), pk2(S[kt2][8 * s2 + 2], S[kt2][8 * s2 + 3]),
                    pk2(S[kt2][8 * s2 + 4], S[kt2][8 * s2 + 5]), pk2(S[kt2][8 * s2 + 6], S[kt2][8 * s2 + 7])};
        Pf[kk] = __builtin_bit_cast(bf16x8, pk);
      }
#pragma unroll
      for (int dvt = 0; dvt < 4; dvt++)
#pragma unroll
        for (int kk = 0; kk < 4; kk++) {
          bf16x8 a = *(const bf16x8*)(sV + (dvt * 32 + l32) * 144 + kk * 32 + hh * 16);
          O[dvt] = MFMA(a, Pf[kk], O[dvt]);
        }
    }
  }
  const float ltot = l_run + __shfl_xor(l_run, 32);
  const float invl = 1.f / ltot;
  if (comp == 1) {
#pragma unroll
    for (int a = 0; a < 4; a++)
#pragma unroll
      for (int i = 0; i < 16; i++) sX[(wave * 64 + a * 16 + i) * 64 + lane] = O[a][i] * invl;
  }
  __syncthreads();
  if (comp == 0) {
    float ss = 0.f;
#pragma unroll
    for (int a = 0; a < 4; a++)
#pragma unroll
      for (int i = 0; i < 16; i++) {
        const float o = O[a][i] * invl - lam * sX[(wave * 64 + a * 16 + i) * 64 + lane];
        O[a][i] = o;
        ss += o * o;
      }
    ss += __shfl_xor(ss, 32);
    const float rs = rsqrtf(ss * (1.f / 128.f) + EPS) * (1.f - lam_init);
    const float* sg = p.in[19] + l * 128;
    u16* yp = ycat + (rowbase + qrow0 + l32) * YW + 512 + h * 128;
#pragma unroll
    for (int a = 0; a < 4; a++)
#pragma unroll
      for (int g4 = 0; g4 < 4; g4++) {
        const int dv = a * 32 + 8 * g4 + 4 * hh;
        const float4 gg = *(const float4*)(sg + dv);
        u32x2 v = {pk2(O[a][4 * g4] * rs * gg.x, O[a][4 * g4 + 1] * rs * gg.y),
                   pk2(O[a][4 * g4 + 2] * rs * gg.z, O[a][4 * g4 + 3] * rs * gg.w)};
        *(u32x2*)(yp + dv) = v;
      }
  }
}

template <class PT> DI void ssm_item(const PT& p, int l, int bl, int g, char* smem) {
  const u16* proj = (const u16*)(p.ws + O_PROJ);
  const u16* m2 = (const u16*)(p.ws + O_M2) + (size_t)(l * 24 + g) * 128 * 256;
  const u16* m13 = (const u16*)(p.ws + O_M13) + (size_t)(l * 24 + g) * 256 * 384;
  u16* yspre = (u16*)(p.ws + O_YSPRE);
  const int tid = opaque_tid() & 255, lane = tid & 63, wave = tid >> 6;
  const int l32 = lane & 31, hh = lane >> 5;
  const size_t rowbase = (size_t)bl * 2048;
  const u16* ua = proj + (rowbase + (size_t)(32 * wave + l32) * 16) * PW + C_U + g * 16 + hh * 8;
  __syncthreads();
  {
    f32x16 acc[4];
#pragma unroll
    for (int a = 0; a < 4; a++)
#pragma unroll
      for (int i = 0; i < 16; i++) acc[a][i] = 0.f;
#pragma unroll 4
    for (int s = 0; s < 16; s++) {
      bf16x8 a = *(const bf16x8*)(ua + (size_t)s * PW);
#pragma unroll
      for (int nt = 0; nt < 4; nt++) {
        bf16x8 b = *(const bf16x8*)(m2 + (size_t)(nt * 32 + l32) * 256 + s * 16 + hh * 8);
        acc[nt] = MFMA(a, b, acc[nt]);
      }
    }
#pragma unroll
    for (int nt = 0; nt < 4; nt++)
#pragma unroll
      for (int i = 0; i < 16; i++) {
        const int c = 32 * wave + crow(i, hh);
        *(float*)(smem + c * 528 + (nt * 32 + l32) * 4) = acc[nt][i];
      }
  }
  __syncthreads();
  if (wave == 0) {
    const float2 a16 = ((const float2*)(p.ws + O_A16))[(l * 24 + g) * 64 + lane];
    float sr = 0.f, si = 0.f;
    float nlr = *(volatile float*)(smem + lane * 4), nli = *(volatile float*)(smem + 256 + lane * 4);
    for (int c = 0; c < 128; c++) {
      const float lr = nlr, li = nli;
      if (c + 1 < 128) {
        nlr = *(volatile float*)(smem + (c + 1) * 528 + lane * 4);
        nli = *(volatile float*)(smem + (c + 1) * 528 + 256 + lane * 4);
      }
      asm volatile("" ::: "memory");
      *(volatile u16*)(smem + c * 528 + lane * 2) = f2bf(sr);
      *(volatile u16*)(smem + c * 528 + 128 + lane * 2) = f2bf(si);
      asm volatile("" ::: "memory");
      const float nr = a16.x * sr - a16.y * si + lr;
      const float ni = a16.x * si + a16.y * sr + li;
      sr = nr; si = ni;
    }
  }
  __syncthreads();
  const float* dsk = p.in[12] + l * 384 + g * 16;
#pragma unroll 1
  for (int half = 0; half < 2; half++) {
    f32x16 acc[4];
#pragma unroll
    for (int a = 0; a < 4; a++)
#pragma unroll
      for (int i = 0; i < 16; i++) acc[a][i] = 0.f;
#pragma unroll 4
    for (int s = 0; s < 16; s++) {
      bf16x8 a = *(const bf16x8*)(ua + (size_t)s * PW);
#pragma unroll
      for (int nt = 0; nt < 4; nt++) {
        if (s <= half * 8 + nt * 2 + 1) {
          bf16x8 b = *(const bf16x8*)(m13 + (size_t)(half * 128 + nt * 32 + l32) * 384 + s * 16 + hh * 8);
          acc[nt] = MFMA(a, b, acc[nt]);
        }
      }
    }
#pragma unroll 4
    for (int s = 0; s < 8; s++) {
      bf16x8 a = *(const bf16x8*)(smem + (32 * wave + l32) * 528 + s * 32 + hh * 16);
#pragma unroll
      for (int nt = 0; nt < 4; nt++) {
        bf16x8 b = *(const bf16x8*)(m13 + (size_t)(half * 128 + nt * 32 + l32) * 384 + 256 + s * 16 + hh * 8);
        acc[nt] = MFMA(a, b, acc[nt]);
      }
    }
#pragma unroll
    for (int nt = 0; nt < 4; nt++) {
      const int n = half * 128 + nt * 32 + l32;
      const int ti = n >> 4, hc = n & 15;
      const float dk = dsk[hc];
      u16 uv[16];
#pragma unroll
      for (int i = 0; i < 16; i++) {
        const int c = 32 * wave + crow(i, hh);
        const size_t tok = rowbase + (size_t)c * 16 + ti;
        uv[i] = proj[tok * PW + C_U + g * 16 + hc];
      }
      asm volatile("" ::: "memory");
#pragma unroll
      for (int i = 0; i < 16; i++) {
        const int c = 32 * wave + crow(i, hh);
        const size_t tok = rowbase + (size_t)c * 16 + ti;
        const float y = acc[nt][i] + dk * bf2f(uv[i]);
        yspre[tok * 384 + g * 16 + hc] = f2bf(gelu_tanh(y));
      }
    }
  }
}

template <class PT> DI void lru_item(const PT& p, int l, int bl, int tc, int hg, char* smem) {
  const u16* proj = (const u16*)(p.ws + O_PROJ);
  float* hloc = (float*)(p.ws + O_HLOC);
  float* pacc = (float*)(p.ws + O_PACC);
  const int tid0 = opaque_tid(), tid = tid0 & 255, lane = tid & 63, wave = tid >> 6;
  const int l32 = lane & 31, hh = lane >> 5;
  const int head = hg * 4 + wave, ch = head * 64 + lane;
  char* sXC = smem + (tid0 >> 6) * 13824;
  char* sGA = sXC + 4608;
  char* sGX = sXC + 9216;
  bf16x8 Wf[2][2][4];
#pragma unroll
  for (int mat = 0; mat < 2; mat++) {
    const float* wp = p.in[mat == 0 ? 22 : 24] + ((size_t)(l * 8 + head) * 64) * 64;
#pragma unroll
    for (int jt = 0; jt < 2; jt++)
#pragma unroll
      for (int s2 = 0; s2 < 4; s2++) {
        const float* q = wp + (size_t)(16 * s2 + 8 * hh) * 64 + jt * 32 + l32;
        u32x4 pk = {pk2(q[0], q[64]), pk2(q[128], q[192]), pk2(q[256], q[320]), pk2(q[384], q[448])};
        Wf[mat][jt][s2] = __builtin_bit_cast(bf16x8, pk);
      }
  }
  const float cw0 = p.in[20][(l * 4 + 0) * 512 + ch], cw1 = p.in[20][(l * 4 + 1) * 512 + ch];
  const float cw2 = p.in[20][(l * 4 + 2) * 512 + ch], cw3 = p.in[20][(l * 4 + 3) * 512 + ch];
  const float cb = p.in[21][l * 512 + ch], ba = p.in[23][l * 512 + ch], bx = p.in[25][l * 512 + ch];
  const float lamv = p.in[26][l * 512 + ch];
  const float sp = (lamv < 0.f) ? (-lamv + log1pf(expf(lamv))) : log1pf(expf(-lamv));
  const int t0 = tc * 64;
  const size_t rowbase = (size_t)bl * 2048;
  const u16* xp = proj + (rowbase + t0) * PW + C_XR + ch;
  float xm3 = 0.f, xm2 = 0.f, xm1 = 0.f;
  if (t0 > 0) {
    xm3 = bf2f(*(xp - (size_t)3 * PW));
    xm2 = bf2f(*(xp - (size_t)2 * PW));
    xm1 = bf2f(*(xp - (size_t)1 * PW));
  }
  float hl = 0.f, P = 1.f;
#pragma unroll 1
  for (int half = 0; half < 2; half++) {
    const float s3 = xm3, s2w = xm2, s1 = xm1;
    {
      float xv[32];
#pragma unroll
      for (int tt = 0; tt < 32; tt++) xv[tt] = bf2f(xp[(size_t)(half * 32 + tt) * PW]);
#pragma unroll
      for (int tt = 0; tt < 32; tt++) {
        const float x0 = xv[tt];
        const float xc = cw0 * xm3 + cw1 * xm2 + cw2 * xm1 + cw3 * x0 + cb;
        xm3 = xm2; xm2 = xm1; xm1 = x0;
        *(u16*)(sXC + tt * 144 + lane * 2) = f2bf(xc);
      }
    }
    asm volatile("s_waitcnt lgkmcnt(0)" ::: "memory");
#pragma unroll
    for (int mat = 0; mat < 2; mat++) {
      f32x16 acc[2];
#pragma unroll
      for (int jt = 0; jt < 2; jt++)
#pragma unroll
        for (int i = 0; i < 16; i++) acc[jt][i] = 0.f;
#pragma unroll
      for (int s2 = 0; s2 < 4; s2++) {
        const bf16x8 xb = *(const bf16x8*)(sXC + l32 * 144 + s2 * 32 + hh * 16);
#pragma unroll
        for (int jt = 0; jt < 2; jt++) acc[jt] = MFMA(Wf[mat][jt][s2], xb, acc[jt]);
      }
      char* sG = mat == 0 ? sGA : sGX;
#pragma unroll
      for (int jt = 0; jt < 2; jt++)
#pragma unroll
        for (int g4 = 0; g4 < 4; g4++) {
          const int jo = (jt * 32 + 8 * g4 + 4 * hh) * 2;
          u32x2 va = {pk2(acc[jt][4 * g4], acc[jt][4 * g4 + 1]), pk2(acc[jt][4 * g4 + 2], acc[jt][4 * g4 + 3])};
          *(u32x2*)(sG + l32 * 144 + jo) = va;
        }
      asm volatile("" ::: "memory");
    }
    asm volatile("s_waitcnt lgkmcnt(0)" ::: "memory");
    float xv2[32];
#pragma unroll
    for (int tt = 0; tt < 32; tt++) xv2[tt] = bf2f(xp[(size_t)(half * 32 + tt) * PW]);
    float y3 = s3, y2 = s2w, y1 = s1;
#pragma unroll
    for (int tt = 0; tt < 32; tt++) {
      const float ra = bf2f(*(const u16*)(sGA + tt * 144 + lane * 2)) + ba;
      const float rx = bf2f(*(const u16*)(sGX + tt * 144 + lane * 2)) + bx;
      const float xc = cw0 * y3 + cw1 * y2 + cw2 * y1 + cw3 * xv2[tt] + cb;
      y3 = y2; y2 = y1; y1 = xv2[tt];
      const float r = sigmoidf_(ra), ig = sigmoidf_(rx);
      const float log_a = -8.f * r * sp;
      const float a = __expf(log_a);
      const float bq = sqrtf(fmaxf(-expm1f(2.f * log_a), 0.f)) * (ig * xc);
      hl = a * hl + bq;
      P *= a;
      const size_t o = (rowbase + t0 + half * 32 + tt) * 512 + ch;
      hloc[o] = hl;
      pacc[o] = P;
    }
    asm volatile("s_waitcnt lgkmcnt(0)" ::: "memory");
  }
}

template <class PT> DI void phase_mixers(const PT& p, int l, unsigned* ctr, char* smem) {
  volatile int* s_item_p = (volatile int*)(smem + SMEM_BYTES - 64);
  constexpr int U_LRU = NB * 32, U_SSM = NB * 12;
  constexpr int U_ATT = NB * 4 * 16;
  constexpr int TOT = U_ATT + U_LRU + U_SSM;
  const int half = opaque_tid() >> 8;
  for (;;) {
    __syncthreads();
    if (threadIdx.x == 0) *s_item_p = (int)atomicAdd(ctr, 1u);
    __syncthreads();
    const int it = *s_item_p;
    if (it >= TOT) break;
    int kind, idx;
    if (it < U_SSM) { kind = 2; idx = it; }
    else if (it < U_SSM + 352) { kind = 0; idx = it - U_SSM; }
    else if (it < U_SSM + 352 + U_LRU) { kind = 1; idx = it - U_SSM - 352; }
    else { kind = 0; idx = it - U_SSM - U_LRU; }
    if (kind == 0) {
      const int qb = 15 - idx / (NB * 4), r = idx % (NB * 4);
      attn_item(p, l, r >> 2, r & 3, qb, smem);
    } else if (kind == 1) {
      const int j = idx * 2 + half;
      lru_item(p, l, j / 64, (j >> 1) & 31, j & 1, smem);
    } else {
      const int j = idx * 2 + half;
      ssm_item(p, l, j / 24, j % 24, smem + half * HALF_LDS);
    }
  }
}

template <class PT> DI void phase_lru2(const PT& p) {
  const u16* proj = (const u16*)(p.ws + O_PROJ);
  const float* hloc = (const float*)(p.ws + O_HLOC);
  const float* pacc = (const float*)(p.ws + O_PACC);
  u16* ycat = (u16*)(p.ws + O_YCAT);
  const int ch = opaque_tid();
  constexpr int NI = NB * 32;
  for (int it = blockIdx.x; it < NI; it += gridDim.x) {
    const int bl = it >> 5, tc = it & 31;
    const size_t rowbase = (size_t)bl * 2048;
    float hin = 0.f;
#pragma unroll 1
    for (int c0 = 0; c0 < tc; c0 += 8) {
      float pe[8], he[8];
#pragma unroll
      for (int k = 0; k < 8; k++) {
        const int c = (c0 + k < tc) ? (c0 + k) : (tc - 1);
        const size_t o = (rowbase + c * 64 + 63) * 512 + ch;
        pe[k] = pacc[o]; he[k] = hloc[o];
      }
#pragma unroll
      for (int k = 0; k < 8; k++) if (c0 + k < tc) hin = pe[k] * hin + he[k];
    }
#pragma unroll 1
    for (int t8 = 0; t8 < 64; t8 += 16) {
      float hl_[16], pa_[16]; u16 gr_[16];
#pragma unroll
      for (int k = 0; k < 16; k++) {
        const size_t row = rowbase + tc * 64 + t8 + k;
        hl_[k] = hloc[row * 512 + ch]; pa_[k] = pacc[row * 512 + ch]; gr_[k] = proj[row * PW + C_GR + ch];
      }
      asm volatile("" ::: "memory");
#pragma unroll
      for (int k = 0; k < 16; k++) {
        const size_t row = rowbase + tc * 64 + t8 + k;
        ycat[row * YW + 1024 + ch] = f2bf((hl_[k] + pa_[k] * hin) * gelu_tanh(bf2f(gr_[k])));
      }
    }
  }
  const int gt = blockIdx.x * 512 + ch, gs = gridDim.x * 512;
  for (int e = gt; e < TC * 16; e += gs) {
    const int r = e >> 4, cc = e & 15;
    unsigned zz = 0u; asm volatile("" : "+v"(zz)); u32x4 z = {zz, zz, zz, zz};
    *(u32x4*)(ycat + (size_t)r * YW + 384 + cc * 8) = z;
  }
}

template <class PT> DI void phase_xattn(const PT& p, char* smem) {
  const u16* qx = (const u16*)(p.ws + O_QX);
  const u16* kx = (const u16*)(p.ws + O_KX);
  const u16* vtx = (const u16*)(p.ws + O_VTX);
  u16* ox = (u16*)(p.ws + O_OX);
  const int tid0 = opaque_tid(), half = tid0 >> 8, tid = tid0 & 255, lane = tid & 63, wave = tid >> 6;
  const int l32 = lane & 31, hh = lane >> 5;
  char* hs = smem + half * HALF_LDS;
  constexpr int NI = (T / 128) * 4;
  const float sc = 0.0625f * 1.4426950408889634f;
  for (int it = opaque_bid() * 2 + half; it < NI; it += opaque_gdim() * 2) {
    const int head = it & 3, rb = it >> 2;
    const int r0 = rb * 128 + wave * 32;
    const int b = rb >> 4;
    f32x16 S[8];
#pragma unroll
    for (int a = 0; a < 8; a++)
#pragma unroll
      for (int i = 0; i < 16; i++) S[a][i] = 0.f;
#pragma unroll 1
    for (int dh = 0; dh < 2; dh++) {
      bf16x8 Qf[8];
      {
        const u16* qp = qx + (size_t)(r0 + l32) * 1024 + head * 256 + dh * 128 + hh * 8;
#pragma unroll
        for (int s = 0; s < 8; s++) Qf[s] = *(const bf16x8*)(qp + s * 16);
      }
#pragma unroll
      for (int ks = 0; ks < 4; ks++) {
        __syncthreads();
#pragma unroll
        for (int i = 0; i < 4; i++) {
          const int c = tid + 256 * i, row = c >> 4, kc = c & 15;
          *(u32x4*)(hs + row * 272 + kc * 16) =
              *(const u32x4*)(kx + (size_t)(b * 256 + ks * 64 + row) * 1024 + head * 256 + dh * 128 + kc * 8);
        }
        __syncthreads();
#pragma unroll
        for (int kt2 = 0; kt2 < 2; kt2++)
#pragma unroll
          for (int s = 0; s < 8; s++) {
            bf16x8 a = *(const bf16x8*)(hs + (kt2 * 32 + l32) * 272 + s * 32 + hh * 16);
            S[ks * 2 + kt2] = MFMA(a, Qf[s], S[ks * 2 + kt2]);
          }
      }
    }
    float mx = -INFINITY;
#pragma unroll
    for (int a = 0; a < 8; a++)
#pragma unroll
      for (int i = 0; i < 16; i++) mx = fmaxf(mx, S[a][i]);
    mx = fmaxf(mx, __shfl_xor(mx, 32));
    const float mm = mx * sc;
    float ps = 0.f;
#pragma unroll
    for (int a = 0; a < 8; a++)
#pragma unroll
      for (int i = 0; i < 16; i++) {
        const float pv = __builtin_amdgcn_exp2f(S[a][i] * sc - mm);
        S[a][i] = pv;
        ps += pv;
      }
    ps += __shfl_xor(ps, 32);
    const float invl = 1.f / ps;
    bf16x8 Pf[16];
#pragma unroll
    for (int kk = 0; kk < 16; kk++) {
      const int a = kk >> 1, s2 = kk & 1;
      u32x4 pk = {pk2(S[a][8 * s2 + 0] * invl, S[a][8 * s2 + 1] * invl), pk2(S[a][8 * s2 + 2] * invl, S[a][8 * s2 + 3] * invl),
                  pk2(S[a][8 * s2 + 4] * invl, S[a][8 * s2 + 5] * invl), pk2(S[a][8 * s2 + 6] * invl, S[a][8 * s2 + 7] * invl)};
      Pf[kk] = __builtin_bit_cast(bf16x8, pk);
    }
#pragma unroll 1
    for (int dvt = 0; dvt < 8; dvt++) {
      __syncthreads();
#pragma unroll
      for (int i = 0; i < 4; i++) {
        const int c = tid + 256 * i, row = c >> 5, kc = c & 31;
        *(u32x4*)(hs + row * 528 + kc * 16) =
            *(const u32x4*)(vtx + (size_t)(b * 1024 + head * 256 + dvt * 32 + row) * 256 + kc * 8);
      }
      __syncthreads();
      f32x16 O;
#pragma unroll
      for (int i = 0; i < 16; i++) O[i] = 0.f;
#pragma unroll
      for (int kk = 0; kk < 16; kk++) {
        bf16x8 a = *(const bf16x8*)(hs + l32 * 528 + kk * 32 + hh * 16);
        O = MFMA(a, Pf[kk], O);
      }
      u16* op = ox + (size_t)(r0 + l32) * 1024 + head * 256 + dvt * 32;
#pragma unroll
      for (int g4 = 0; g4 < 4; g4++) {
        u32x2 v = {pk2(O[4 * g4], O[4 * g4 + 1]), pk2(O[4 * g4 + 2], O[4 * g4 + 3])};
        *(u32x2*)(op + 8 * g4 + 4 * hh) = v;
      }
    }
  }
}

template <class PT> DI void phase_ffn_act(const PT& p, int l) {
  const u16* up = (const u16*)(p.ws + O_UP);
  u16* act = (u16*)(p.ws + O_ACT);
  const float* cw = p.in[38] + (size_t)l * 3 * DUP;
  const float* cb = p.in[39] + (size_t)l * DUP;
  constexpr int CG = DFF / 8;
  constexpr int TB = 16;
  constexpr int NU = (TC / TB) * CG;
  const int tid = opaque_tid();
  for (int u = blockIdx.x * 512 + tid; u < NU; u += gridDim.x * 512) {
    const int tb = u / CG, cg = u - tb * CG;
    const int row0 = tb * TB;
    const int c0 = cg * 8;
    float wv[3][8], wg[3][8], bv[8], bgt[8];
#pragma unroll
    for (int j = 0; j < 3; j++) {
      const float4 a0 = *(const float4*)(cw + j * DUP + c0), a1 = *(const float4*)(cw + j * DUP + c0 + 4);
      const float4 b0 = *(const float4*)(cw + j * DUP + DFF + c0), b1 = *(const float4*)(cw + j * DUP + DFF + c0 + 4);
      wv[j][0] = a0.x; wv[j][1] = a0.y; wv[j][2] = a0.z; wv[j][3] = a0.w; wv[j][4] = a1.x; wv[j][5] = a1.y; wv[j][6] = a1.z; wv[j][7] = a1.w;
      wg[j][0] = b0.x; wg[j][1] = b0.y; wg[j][2] = b0.z; wg[j][3] = b0.w; wg[j][4] = b1.x; wg[j][5] = b1.y; wg[j][6] = b1.z; wg[j][7] = b1.w;
    }
    {
      const float4 a0 = *(const float4*)(cb + c0), a1 = *(const float4*)(cb + c0 + 4);
      const float4 b0 = *(const float4*)(cb + DFF + c0), b1 = *(const float4*)(cb + DFF + c0 + 4);
      bv[0] = a0.x; bv[1] = a0.y; bv[2] = a0.z; bv[3] = a0.w; bv[4] = a1.x; bv[5] = a1.y; bv[6] = a1.z; bv[7] = a1.w;
      bgt[0] = b0.x; bgt[1] = b0.y; bgt[2] = b0.z; bgt[3] = b0.w; bgt[4] = b1.x; bgt[5] = b1.y; bgt[6] = b1.z; bgt[7] = b1.w;
    }
    float v2[8], v1[8], g2[8], g1[8];
#pragma unroll
    for (int e = 0; e < 8; e++) { v2[e] = v1[e] = g2[e] = g1[e] = 0.f; }
    if ((row0 & 2047) != 0) {
      const u32x4 a2 = *(const u32x4*)(up + (size_t)(row0 - 2) * DUP + c0);
      const u32x4 a1 = *(const u32x4*)(up + (size_t)(row0 - 1) * DUP + c0);
      const u32x4 b2 = *(const u32x4*)(up + (size_t)(row0 - 2) * DUP + DFF + c0);
      const u32x4 b1 = *(const u32x4*)(up + (size_t)(row0 - 1) * DUP + DFF + c0);
#pragma unroll
      for (int e = 0; e < 4; e++) {
        v2[2 * e] = bflo(a2[e]); v2[2 * e + 1] = bfhi(a2[e]);
        v1[2 * e] = bflo(a1[e]); v1[2 * e + 1] = bfhi(a1[e]);
        g2[2 * e] = bflo(b2[e]); g2[2 * e + 1] = bfhi(b2[e]);
        g1[2 * e] = bflo(b1[e]); g1[2 * e + 1] = bfhi(b1[e]);
      }
    }
#pragma unroll 1
    for (int t8 = 0; t8 < TB; t8 += 8) {
      u32x4 ar[8], br[8];
#pragma unroll
      for (int k = 0; k < 8; k++) {
        ar[k] = *(const u32x4*)(up + (size_t)(row0 + t8 + k) * DUP + c0);
        br[k] = *(const u32x4*)(up + (size_t)(row0 + t8 + k) * DUP + DFF + c0);
      }
      asm volatile("" ::: "memory");
#pragma unroll
      for (int k = 0; k < 8; k++) {
        float v0[8], g0[8], o[8];
#pragma unroll
        for (int e = 0; e < 4; e++) {
          v0[2 * e] = bflo(ar[k][e]); v0[2 * e + 1] = bfhi(ar[k][e]);
          g0[2 * e] = bflo(br[k][e]); g0[2 * e + 1] = bfhi(br[k][e]);
        }
#pragma unroll
        for (int e = 0; e < 8; e++) {
          const float val = wv[0][e] * v2[e] + wv[1][e] * v1[e] + wv[2][e] * v0[e] + bv[e];
          const float gat = wg[0][e] * g2[e] + wg[1][e] * g1[e] + wg[2][e] * g0[e] + bgt[e];
          o[e] = gat * sigmoidf_(gat) * val;
          v2[e] = v1[e]; v1[e] = v0[e]; g2[e] = g1[e]; g1[e] = g0[e];
        }
        u32x4 ov = {pk2(o[0], o[1]), pk2(o[2], o[3]), pk2(o[4], o[5]), pk2(o[6], o[7])};
        *(u32x4*)(act + (size_t)(row0 + t8 + k) * DFF + c0) = ov;
      }
    }
  }
}

DI g8::Sched2 mk_sched(const void* A, const void* B, int M, int N, int lda, int ldb) {
  g8::Sched2 s;
  s.A0 = (const char*)A; s.B0 = (const char*)B; s.A1 = nullptr; s.B1 = nullptr;
  s.nM0 = M / 256; s.nN0 = N / 256; s.nM1 = 0; s.nN1 = 0;
  s.tsA = (size_t)256 * lda * 2; s.tsB = (size_t)256 * ldb * 2;
  s.G = gridDim.x; s.c = blockIdx.x;
  return s;
}

__global__ void __launch_bounds__(512) mega(Params p0) {
  extern __shared__ __attribute__((aligned(16))) char smem[];
  LAS unsigned char* lds = (LAS unsigned char*)smem;
  cg::grid_group grid = cg::this_grid();
  unsigned* bar = (unsigned*)(p0.ws + O_BAR);
  unsigned* ctrs = bar + 64;
  unsigned target = 0; (void)target;
  volatile unsigned* xst = (volatile unsigned*)(smem + SMEM_BYTES - 48);
  if (threadIdx.x == 0) { xst[0] = 0u; xst[1] = 0u; }
  __syncthreads();
  const XcdBarrier xbar = xcd_barrier_post((unsigned*)(p0.ws + O_XB), xst);
#ifdef PROBE_A
  unsigned ta = 0, tb = 0;
  unsigned tlast = (unsigned)__builtin_amdgcn_s_memrealtime();
#define TICK(k) do { const unsigned _n = (unsigned)__builtin_amdgcn_s_memrealtime(); if ((PROBE_A >> (k)) & 1) ta += _n - tlast; if ((PROBE_B >> (k)) & 1) tb += _n - tlast; tlast = _n; } while (0)
#else
#define TICK(k) do {} while (0)
#endif

  if (blockIdx.x == 0 && threadIdx.x == 0) {
    const float** tab = (const float**)(p0.ws + O_TAB);
#pragma unroll
    for (int i = 0; i < 42; i++) tab[i] = p0.in[i];
  }
  phase_init(p0);
  phase_ssm_setup(p0, smem);
  phase_convert_weights(p0, 0, smem);
  rmsnorm_rows(p0.in[1], p0.in[32], (u16*)(p0.ws + O_MEMN), MEMR);
  TICK(0);
  grid.sync();
  TICK(11);
  Ctx p;
  p.in = (const float* const*)(p0.ws + O_TAB); p.ws = launder(p0.ws); p.out = launder(p0.out);

  for (int l = 0; l < DEPTH; l++) {
    const u16* wb = (const u16*)(p.ws + O_W);
    if (l > 0) {
      phase_convert_weights(p, l, smem);
      rmsnorm_rows(p.in[1], p.in[32] + l * 1024, (u16*)(p.ws + O_MEMN), MEMR);
      TICK(1);
      xcd_barrier(xbar); p.ws = launder(p0.ws); p.out = launder(p0.out);
      TICK(11);
    }
    rmsnorm_rows(l == 0 ? p.in[0] : p.out, p.in[3] + l * 1024, (u16*)(p.ws + O_HN), T);
    {
      g8::Sched2 s = mk_sched(p.ws + O_MEMN, wb + W_KV, MEMR, 1024, 1024, 1024);
      s.A1 = (const char*)(wb + W_KV + (size_t)1024 * 1024); s.B1 = p.ws + O_MEMN; s.nM1 = 4; s.nN1 = MEMR / 256;
      g8::EpiBf16 e{(u16*)(p.ws + O_KX), 1024, 1024, (u16*)(p.ws + O_VTX), 8, 1024};
      g8::gemm_phase<true>(lds, 1024, 1024, 1024, s, e);
    }
    TICK(2);
    xcd_barrier(xbar); p.ws = launder(p0.ws); p.out = launder(p0.out);
    TICK(11);
    for (int chunk = 0; chunk < NCHUNK; chunk++) {
      float* x = p.out + (size_t)chunk * TC * 1024;
      const char* hnc = p.ws + O_HN + (size_t)chunk * TC * 1024 * 2;
      {
        g8::Sched2 s = mk_sched(hnc, wb + W_IN, TC, PWP, 1024, 1024);
        s.A1 = (const char*)(wb + W_V); s.B1 = hnc; s.nM1 = 2; s.nN1 = TC / 256;
        g8::EpiProj e{(u16*)(p.ws + O_PROJ), (const float2*)(p.ws + O_ROPE) + (size_t)chunk * TC * 32, (u16*)(p.ws + O_VT)};
        g8::gemm_phase<true>(lds, 1024, 1024, 1024, s, e);
      }
      TICK(3);
      xcd_barrier(xbar); p.ws = launder(p0.ws); p.out = launder(p0.out);
      TICK(11);
      phase_mixers(p, l, ctrs + l * NCHUNK + chunk, smem);
      TICK(4);
      xcd_barrier(xbar); p.ws = launder(p0.ws); p.out = launder(p0.out);
      TICK(11);
      {
        g8::Sched2 s = mk_sched(p.ws + O_YSPRE, wb + W_GLU, TC, 768, 384, 384);
        g8::EpiGlu e{(u16*)(p.ws + O_YCAT), p.in[14] + l * 768};
        g8::gemm_phase<true>(lds, 384, 384, 384, s, e);
      }
      phase_lru2(p);
      TICK(5);
      xcd_barrier(xbar); p.ws = launder(p0.ws); p.out = launder(p0.out);
      TICK(11);
      {
        g8::SchedMerge s;
        s.A = p.ws + O_YCAT; s.B = (const char*)(wb + W_BR); s.nM = TC / 256; s.nN = 4;
        s.tsA = (size_t)256 * YW * 2; s.tsB = (size_t)256 * YW * 2; s.G = gridDim.x; s.c = blockIdx.x;
        g8::EpiGateZ e{(const u16*)(p.ws + O_PROJ), (u16*)(p.ws + O_Z)};
        g8::gemm_phase<true>(lds, 512, YW, YW, s, e);
      }
      TICK(6);
      xcd_barrier(xbar); p.ws = launder(p0.ws); p.out = launder(p0.out);
      TICK(11);
      {
        g8::Sched2 s = mk_sched(p.ws + O_Z, wb + W_OUT, TC, 1024, 3072, 1024);
        g8::EpiResid e{x, l == 0 ? p.in[0] + (size_t)chunk * TC * 1024 : x};
        g8::gemm_phase<false, 16>(lds, 3072, 3072, 1024, s, e);
      }
      TICK(7);
      xcd_barrier(xbar); p.ws = launder(p0.ws); p.out = launder(p0.out);
      TICK(11);
    }
    rmsnorm_rows(p.out, p.in[31] + l * 1024, (u16*)(p.ws + O_HN), T);
    TICK(2);
    xcd_barrier(xbar); p.ws = launder(p0.ws); p.out = launder(p0.out);
    TICK(11);
    {
      g8::Sched2 s = mk_sched(p.ws + O_HN, wb + W_Q, T, 1024, 1024, 1024);
      g8::EpiBf16 e{(u16*)(p.ws + O_QX), 1024, 1024, nullptr, 0, 0};
      g8::gemm_phase<true>(lds, 1024, 1024, 1024, s, e);
    }
    TICK(8);
    xcd_barrier(xbar); p.ws = launder(p0.ws); p.out = launder(p0.out);
    TICK(11);
    phase_xattn(p, smem);
    TICK(9);
    xcd_barrier(xbar); p.ws = launder(p0.ws); p.out = launder(p0.out);
    TICK(11);
    {
      g8::Sched2 s = mk_sched(p.ws + O_OX, wb + W_O, T, 1024, 1024, 1024);
      g8::EpiResid e{p.out, p.out};
      g8::gemm_phase<false>(lds, 1024, 1024, 1024, s, e);
    }
    TICK(7);
    xcd_barrier(xbar); p.ws = launder(p0.ws); p.out = launder(p0.out);
    TICK(11);
    rmsnorm_rows(p.out, p.in[36] + l * 1024, (u16*)(p.ws + O_HN), T);
    TICK(2);
    xcd_barrier(xbar); p.ws = launder(p0.ws); p.out = launder(p0.out);
    TICK(11);
    for (int chunk = 0; chunk < NCHUNK; chunk++) {
      float* x = p.out + (size_t)chunk * TC * 1024;
      const char* hnc = p.ws + O_HN + (size_t)chunk * TC * 1024 * 2;
      {
        g8::Sched2 s = mk_sched(hnc, wb + W_UP, TC, DUP, 1024, 1024);
        g8::EpiBf16 e{(u16*)(p.ws + O_UP), DUP, DUP, nullptr, 0, 0};
        g8::gemm_phase<true>(lds, 1024, 1024, 1024, s, e);
      }
      TICK(8);
      xcd_barrier(xbar); p.ws = launder(p0.ws); p.out = launder(p0.out);
      TICK(11);
      phase_ffn_act(p, l);
      TICK(10);
      xcd_barrier(xbar); p.ws = launder(p0.ws); p.out = launder(p0.out);
      TICK(11);
      {
        g8::Sched2 s = mk_sched(p.ws + O_ACT, wb + W_DOWN, TC, 1024, DFF, DFF);
        g8::EpiResid e{x, x};
        g8::gemm_phase<false>(lds, DFF, DFF, DFF, s, e);
      }
      TICK(7);
      xcd_barrier(xbar); p.ws = launder(p0.ws); p.out = launder(p0.out);
      TICK(11);
    }
  }
#ifdef PROBE_A
  {
    unsigned* mw = (unsigned*)(p0.ws + O_BAR) + 128;
    if (blockIdx.x == 0 && threadIdx.x == 0) {
      __hip_atomic_store(mw, ta / 100u, __ATOMIC_RELAXED, __HIP_MEMORY_SCOPE_AGENT);
      const unsigned t0 = (unsigned)__builtin_amdgcn_s_memrealtime();
      while ((unsigned)__builtin_amdgcn_s_memrealtime() - t0 < tb) __builtin_amdgcn_s_sleep(8);
    }
    xcd_barrier(xbar);
    final_norm(p.out, p.in[41], __hip_atomic_load(mw, __ATOMIC_RELAXED, __HIP_MEMORY_SCOPE_AGENT));
  }
#else
  final_norm(p.out, p.in[41], 0u);
#endif
}

extern "C" void kernel_launch(void* const* d_in, const int* in_sizes, int n_in, void* d_out, int out_size,
                              void* d_ws, size_t ws_size, hipStream_t stream) {
  static int grid_blocks = 0;
  if (!grid_blocks) {
    int dev = 0, cus = 0, per_cu = 0;
    (void)hipGetDevice(&dev);
    (void)hipDeviceGetAttribute(&cus, hipDeviceAttributeMultiprocessorCount, dev);
    if (hipFuncSetAttribute((const void*)mega, hipFuncAttributeMaxDynamicSharedMemorySize, SMEM_BYTES) != hipSuccess)
      fprintf(stderr, "hipFuncSetAttribute failed\n");
    (void)hipOccupancyMaxActiveBlocksPerMultiprocessor(&per_cu, mega, 512, SMEM_BYTES);
    if (per_cu < 1) per_cu = 1;
    grid_blocks = cus;
    if (grid_blocks > NBLK) grid_blocks = NBLK;
  }
  if (ws_size < O_XB + 16384 || n_in < 42) {
    fprintf(stderr, "workspace too small: %zu < %zu\n", ws_size, (size_t)O_END);
    return;
  }
  Params p{};
  for (int i = 0; i < 42; i++) p.in[i] = (const float*)d_in[i];
  p.out = (float*)d_out;
  p.ws = (char*)d_ws;
  (void)hipMemsetAsync(d_ws, 0, 4096, stream);
  (void)hipMemsetAsync((char*)d_ws + O_XB, 0, 16384, stream);
  void* args[] = {&p};
  hipError_t e = hipLaunchCooperativeKernel((void*)mega, dim3(grid_blocks), dim3(512), args, SMEM_BYTES, stream);
  if (e != hipSuccess) fprintf(stderr, "cooperative launch failed: %s (grid %d)\n", hipGetErrorString(e), grid_blocks);
}
```

```cpp
#include <hip/hip_runtime.h>
#include <hip/hip_cooperative_groups.h>
#include <cstdio>
namespace cg = cooperative_groups;

#define DI __device__ __forceinline__
#define LAS __attribute__((address_space(3)))
typedef unsigned short u16;
typedef __attribute__((ext_vector_type(8))) short bf16x8;
typedef __attribute__((ext_vector_type(16))) float f32x16;
typedef __attribute__((ext_vector_type(4))) float f32x4;
typedef __attribute__((ext_vector_type(4))) unsigned u32x4;
typedef __attribute__((ext_vector_type(2))) unsigned u32x2;
typedef __bf16 bf16v2 __attribute__((ext_vector_type(2)));
typedef float f32v2 __attribute__((ext_vector_type(2)));
#define MFMA(a, b, c) __builtin_amdgcn_mfma_f32_32x32x16_bf16((a), (b), (c), 0, 0, 0)

constexpr int D = 1024, BATCH = 16, SEQ = 2048, DEPTH = 4, T = BATCH * SEQ;
constexpr int NB = 8;
constexpr int TC = NB * SEQ;
constexpr int NCHUNK = BATCH / NB;
constexpr int DIN = 6016, DFF = 2816, DUP = 2 * DFF;
constexpr int PW = 5504, PWP = 5632;
constexpr int C_U = 0, C_Q = 384, C_K = 896, C_XR = 1408, C_GR = 1920, C_G = 2432;
constexpr int YW = 1536;
constexpr int MEMR = BATCH * 256;
constexpr float EPS = 1e-6f;
constexpr int NBLK = 256;

constexpr size_t al256(size_t x) { return (x + 255) & ~(size_t)255; }
constexpr size_t W_IN = 0;
constexpr size_t W_V = W_IN + (size_t)PWP * 1024;
constexpr size_t W_GLU = W_V + 512 * 1024;
constexpr size_t W_BR = W_GLU + 768 * 384;
constexpr size_t W_OUT = W_BR + 1024 * YW;
constexpr size_t W_Q = W_OUT + 1024 * 1024;
constexpr size_t W_KV = W_Q + 1024 * 1024;
constexpr size_t W_O = W_KV + 2048 * 1024;
constexpr size_t W_UP = W_O + 1024 * 1024;
constexpr size_t W_DOWN = W_UP + (size_t)DUP * 1024;
constexpr size_t W_END = W_DOWN + (size_t)1024 * DFF;

constexpr size_t O_BAR = 0;
constexpr size_t O_LAM = 1024;
constexpr size_t O_TAB = 2048;
constexpr size_t O_W = 4096;
constexpr size_t O_M2 = al256(O_W + W_END * 2);
constexpr size_t O_M13 = al256(O_M2 + (size_t)96 * 128 * 256 * 2);
constexpr size_t O_A16 = al256(O_M13 + (size_t)96 * 256 * 384 * 2);
constexpr size_t O_ROPE = al256(O_A16 + 96 * 64 * 8);
constexpr size_t O_MEMN = al256(O_ROPE + (size_t)T * 32 * 8);
constexpr size_t O_KX = al256(O_MEMN + (size_t)MEMR * 1024 * 2);
constexpr size_t O_VTX = al256(O_KX + (size_t)MEMR * 1024 * 2);
constexpr size_t O_HN = al256(O_VTX + (size_t)MEMR * 1024 * 2);
constexpr size_t O_PROJ = al256(O_HN + (size_t)T * 1024 * 2);
constexpr size_t O_VT = al256(O_PROJ + (size_t)TC * DUP * 2);
constexpr size_t O_YSPRE = al256(O_VT + (size_t)NB * 512 * 2048 * 2);
constexpr size_t O_YCAT = al256(O_YSPRE + (size_t)TC * 384 * 2);
constexpr size_t O_HLOC = al256(O_YCAT + (size_t)TC * YW * 2);
constexpr size_t O_PACC = al256(O_HLOC + (size_t)TC * 512 * 4);
constexpr size_t O_MERGED = al256(O_PACC + (size_t)TC * 512 * 4);
constexpr size_t O_END = al256(O_MERGED + (size_t)TC * 1024 * 2);
constexpr size_t O_QX = O_PROJ;
constexpr size_t O_OX = O_PROJ + (size_t)T * 1024 * 2;
constexpr size_t O_UP = O_PROJ;
constexpr size_t O_ACT = O_VT;
constexpr size_t O_Z = O_HLOC;
static_assert(O_ACT + (size_t)TC * DFF * 2 <= O_MERGED, "act alias");
static_assert(O_Z + (size_t)TC * 3072 * 2 <= O_END, "z alias");
constexpr size_t O_XB = O_END;
static_assert(O_XB + 16384 <= (size_t)536870912, "workspace");
static_assert((size_t)T * 1024 * 4 <= (size_t)TC * DUP * 2, "qx/ox alias");

constexpr int HALF_LDS = 128 * 528 + 64;
constexpr int SMEM_BYTES = 2 * HALF_LDS;

struct Params {
  const float* in[42];
  float* out;
  char* ws;
};

struct Ctx {
  const float* const* in;
  float* out;
  char* ws;
};

DI float bf2f(u16 v) { return __uint_as_float(((unsigned)v) << 16); }
DI float bflo(unsigned v) { return __uint_as_float(v << 16); }
DI float bfhi(unsigned v) { return __uint_as_float(v & 0xffff0000u); }
DI unsigned pk2(float lo, float hi) {
  f32v2 f = {lo, hi};
  bf16v2 b = __builtin_convertvector(f, bf16v2);
  return __builtin_bit_cast(unsigned, b);
}
DI u16 f2bf(float x) { return (u16)(pk2(x, 0.f) & 0xffffu); }
DI int crow(int i, int hh) { return (i & 3) + 8 * (i >> 2) + 4 * hh; }
DI float sigmoidf_(float x) { return 1.f / (1.f + __expf(-x)); }
DI float gelu_tanh(float x) {
  const float u2 = 1.5957691216057308f * (x + 0.044715f * x * x * x);
  return x / (1.f + __expf(-u2));
}
DI int opaque_bid() { int b = blockIdx.x; asm volatile("" : "+s"(b)); return b; }
DI int opaque_gdim() { int g = gridDim.x; asm volatile("" : "+s"(g)); return g; }
DI int opaque_tid() { int t = threadIdx.x; asm volatile("" : "+v"(t)); return t; }
template <class P> DI P* launder(P* p) { asm volatile("" : "+s"(p)); return p; }
DI int swap23(int t) { return (t & ~12) | ((t & 4) << 1) | ((t & 8) >> 1); }

#define XB_TMO      128
#define XB_XCNT(j)  (256  + 64 * (j))
#define XB_XSUB(j)  (1280 + 64 * (j))
#define XB_XGEN(j)  (2304 + 64 * (j))
#define XB_TOP      3328
#define XB_TOPGEN   3392
#define XB_SPIN_CAP (1u << 18)
DI unsigned xb_ld(unsigned* p)              { return __hip_atomic_load(p, __ATOMIC_RELAXED, __HIP_MEMORY_SCOPE_AGENT); }
DI unsigned xb_add(unsigned* p, unsigned v) { return __hip_atomic_fetch_add(p, v, __ATOMIC_RELAXED, __HIP_MEMORY_SCOPE_AGENT); }
DI unsigned xb_xcc_id() { return (unsigned)__builtin_amdgcn_s_getreg((3 << 11) | 20) & 0xFu; }
#define XB_SPIN(cond, bar) do { unsigned _sp = 0; while (cond) { __builtin_amdgcn_s_sleep(1); \
    if ((++_sp & 255u) == 0u) { if (xb_ld(&(bar)[XB_TMO])) break; if (_sp > XB_SPIN_CAP) { atomicAdd(&(bar)[XB_TMO], 1u); break; } } } } while (0)
struct XcdBarrier { unsigned* bar; unsigned x; volatile unsigned* st; };
DI XcdBarrier xcd_barrier_post(unsigned* bar, volatile unsigned* st) {
  XcdBarrier b; b.bar = bar; b.x = xb_xcc_id(); b.st = st;
  if (threadIdx.x == 0) (void)xb_add(&bar[XB_XCNT(b.x)], 1u);
  return b;
}
DI void xcd_barrier_complete(unsigned* bar, unsigned x, unsigned& nloc, unsigned& nx) {
  const unsigned G = gridDim.x;
  unsigned sum, cnt, mine, sp = 0u;
  for (;;) {
    sum = 0u; cnt = 0u; mine = 0u;
#pragma unroll
    for (unsigned j = 0; j < 16; ++j) { const unsigned c = xb_ld(&bar[XB_XCNT(j)]); sum += c; cnt += (c > 0u) ? 1u : 0u; mine = (j == x) ? c : mine; }
    if (sum == G) break;
    __builtin_amdgcn_s_sleep(1);
    if ((++sp & 255u) == 0u) { if (xb_ld(&bar[XB_TMO])) break; if (sp > XB_SPIN_CAP) { atomicAdd(&bar[XB_TMO], 1u); break; } }
  }
  nloc = mine > 0u ? mine : 1u; nx = cnt > 0u ? cnt : 1u;
}
DI void xcd_barrier(const XcdBarrier& b) {
  asm volatile("s_waitcnt vmcnt(0)" ::: "memory");
  __syncthreads();
  if (threadIdx.x == 0) {
    unsigned* bar = b.bar;
    __builtin_amdgcn_s_waitcnt(0);
    unsigned nloc = b.st[0], nx = b.st[1];
    if (nloc == 0u) { xcd_barrier_complete(bar, b.x, nloc, nx); b.st[0] = nloc; b.st[1] = nx; }
    const unsigned old = xb_add(&bar[XB_XSUB(b.x)], 1u);
    const unsigned gen = old / nloc;
    if (old + 1u == (gen + 1u) * nloc) {
      __builtin_amdgcn_fence(__ATOMIC_RELEASE, "agent");
      asm volatile("s_waitcnt vmcnt(0)" ::: "memory");
      const unsigned og = xb_add(&bar[XB_TOP], 1u);
      const unsigned tg = og / nx;
      if (og + 1u == (tg + 1u) * nx) xb_add(&bar[XB_TOPGEN], 1u);
      else XB_SPIN(xb_ld(&bar[XB_TOPGEN]) == tg, bar);
      __builtin_amdgcn_fence(__ATOMIC_ACQUIRE, "agent");
      xb_add(&bar[XB_XGEN(b.x)], 1u);
      asm volatile("s_waitcnt vmcnt(0)" ::: "memory");
    } else {
      XB_SPIN(xb_ld(&bar[XB_XGEN(b.x)]) == gen, bar);
      __builtin_amdgcn_fence(__ATOMIC_ACQUIRE, "agent");
      asm volatile("s_waitcnt vmcnt(0)" ::: "memory");
    }
  }
  __syncthreads();
}

namespace g8 {
constexpr int BK = 64, HALF = 128, HTB = HALF * BK * 2;
DI int lds_byte(int r, int c) { const int st = (r >> 4) * 2 + (c >> 5), rr = r & 15, cc = c & 31, ob = rr * 64 + cc * 2; return st * 1024 + (ob ^ (((ob >> 9) & 1) << 5)); }
DI void stage_rc(int b, int& R, int& C) { const int st = b / 1024, sb = b % 1024, swz = sb ^ (((sb >> 9) & 1) << 5); R = (st >> 1) * 16 + swz / 64; C = (st & 1) * 32 + (swz % 64) / 2; }
DI int perm32(int rho) { const int n = rho >> 4, i = rho & 15; return 8 * (i >> 2) + 4 * n + (i & 3); }
struct Unit { const char* a; const char* b; int pm, pn, kind; };

DI void remap(int L, int nM, int nN, int& pm, int& pn) {
  const int nwg = nM * nN;
  const int q = nwg / 8, r = nwg % 8, xcd = L % 8, off = L / 8;
  const int wgid = (xcd < r ? xcd * (q + 1) : r * (q + 1) + (xcd - r) * q) + off;
  const int nig = 8 * nN, gid = wgid / nig, fm = gid * 8, gsz = (nM - fm) < 8 ? (nM - fm) : 8;
  pm = fm + ((wgid % nig) % gsz);
  pn = (wgid % nig) / gsz;
}
struct Sched2 {
  const char *A0, *B0, *A1, *B1;
  int nM0, nN0, nM1, nN1;
  size_t tsA, tsB;
  int G, c;
  DI bool next(int i, Unit& u) const {
    const int L = i * G + c, n0 = nM0 * nN0;
    if (L < n0) { remap(L, nM0, nN0, u.pm, u.pn); u.a = A0 + (size_t)u.pm * tsA; u.b = B0 + (size_t)u.pn * tsB; u.kind = 0; return true; }
    if (L < n0 + nM1 * nN1) { remap(L - n0, nM1, nN1, u.pm, u.pn); u.a = A1 + (size_t)u.pm * tsA; u.b = B1 + (size_t)u.pn * tsB; u.kind = 1; return true; }
    return false;
  }
};
struct SchedMerge {
  const char *A, *B;
  int nM, nN;
  size_t tsA, tsB;
  int G, c;
  DI bool next(int i, Unit& u) const {
    const int L = i * G + c, nt = nM * nN;
    if (L >= 3 * nt) return false;
    const int br = L / nt;
    remap(L - br * nt, nM, nN, u.pm, u.pn);
    u.a = A + (size_t)u.pm * tsA + br * 1024; u.b = B + (size_t)u.pn * tsB + br * 1024; u.kind = br;
    return true;
  }
};

template <bool PERM, int BWRAP = 0, class Sched, class Epi>
DI void gemm_phase(LAS unsigned char* lds, const int K, const int lda, const int ldb, const Sched& S, const Epi& E) {
  const int tid = opaque_tid(), wid = __builtin_amdgcn_readfirstlane(tid >> 6), lane = tid & 63, wr = wid >> 2, wc = wid & 3, fr = lane & 15, fq = lane >> 4;
  const int nt = K / BK;
  unsigned voffA[2], voffB[2];
#pragma unroll
  for (int i = 0; i < 2; ++i) {
    int R, C; stage_rc(tid * 16 + i * 8192, R, C);
    const int Rb = PERM ? ((R & ~31) + perm32(R & 31)) : R;
    voffA[i] = (unsigned)(R * lda + C) * 2u; voffB[i] = (unsigned)(Rb * ldb + C) * 2u;
  }
  const size_t kstep = (size_t)(BK * 2);
  const size_t hstepA = (size_t)HALF * lda * 2, hstepB = (size_t)HALF * ldb * 2;
  const unsigned ldsw = (unsigned)wid * 1024u;
  const int aoff = lds_byte(wr * 64 + fr, fq * 8), boff = lds_byte(wc * 32 + fr, fq * 8);
#define G8_SA(b, h) (((b) * 2 + (h)) * HTB)
#define G8_SB(b, h) ((4 + (b) * 2 + (h)) * HTB)
#define G8_STAGE(bufoff, gbase, voff) do { _Pragma("unroll") for (int _i = 0; _i < 2; ++_i) \
    __builtin_amdgcn_global_load_lds((const unsigned*)((const char*)(gbase) + (voff)[_i]), (LAS unsigned*)(lds + (bufoff) + ldsw + _i * 8192), 16, 0, 0); } while (0)
#define G8_LDA(dst, b, h) do { _Pragma("unroll") for (int m = 0; m < 4; ++m) _Pragma("unroll") for (int k = 0; k < 2; ++k) dst[m][k] = *(const LAS bf16x8*)(lds + G8_SA(b, h) + aoff + m * 2048 + k * 1024); } while (0)
#define G8_LDB(dst, b, h) do { _Pragma("unroll") for (int n = 0; n < 2; ++n) _Pragma("unroll") for (int k = 0; k < 2; ++k) dst[n][k] = *(const LAS bf16x8*)(lds + G8_SB(b, h) + boff + n * 2048 + k * 1024); } while (0)
#define G8_MMA(ai, bj, At, Bt) do { __builtin_amdgcn_s_setprio(1); _Pragma("unroll") for (int m = 0; m < 4; ++m) _Pragma("unroll") for (int n = 0; n < 2; ++n) _Pragma("unroll") for (int k = 0; k < 2; ++k) \
    acc[ai][bj][m][n] = __builtin_amdgcn_mfma_f32_16x16x32_bf16(Bt[n][k], At[m][k], acc[ai][bj][m][n], 0, 0, 0); __builtin_amdgcn_s_setprio(0); } while (0)
#define G8_WAIT_V(n) asm volatile("s_waitcnt vmcnt(" #n ")" ::: "memory")
#define G8_WAIT_L(n) asm volatile("s_waitcnt lgkmcnt(" #n ")" ::: "memory")
#define G8_BAR __builtin_amdgcn_s_barrier()
#define G8_SCHED __builtin_amdgcn_sched_barrier(0)
  Unit cur, nxt; int ui = 0;
  if (!S.next(0, cur)) return;
  f32x4 acc[2][2][4][2];
  E.init(acc, cur, wr, wc, fr, fq);
  bf16x8 At[4][2], B0[2][2], B1[2][2];
  const char* cA = cur.a; const char* cB = cur.b;
  G8_STAGE(G8_SB(0, 0), cB, voffB); G8_STAGE(G8_SA(0, 0), cA, voffA); G8_STAGE(G8_SB(0, 1), cB + hstepB, voffB); G8_STAGE(G8_SA(0, 1), cA + hstepA, voffA);
  if (wr == 1) G8_BAR;
  G8_WAIT_V(4); G8_BAR;
  G8_STAGE(G8_SB(1, 0), cB + kstep, voffB); G8_STAGE(G8_SA(1, 0), cA + kstep, voffA); G8_STAGE(G8_SB(1, 1), cB + hstepB + kstep, voffB);
  G8_WAIT_V(6); G8_BAR;
  for (;;) {
    const bool has_next = S.next(ui + 1, nxt);
    const char* nA = has_next ? nxt.a : cA; const char* nB = has_next ? nxt.b : cB;
#pragma unroll 1
    for (int t = 0; t < nt; t += 2) {
      const bool last = (t == nt - 2);
      const char* a1 = cA + (size_t)(t + 1) * kstep;
      const char* a2 = last ? nA : cA + (size_t)(t + 2) * kstep;
      const char* b2 = last ? nB : cB + (size_t)(BWRAP ? ((t + 2) & (BWRAP - 1)) : (t + 2)) * kstep;
      const char* a3 = a2 + kstep; const char* b3 = b2 + kstep;
      G8_LDB(B0, 0, 0); G8_SCHED; G8_LDA(At, 0, 0); G8_STAGE(G8_SA(1, 1), a1 + hstepA, voffA);
      G8_WAIT_L(8); G8_BAR; G8_WAIT_L(0); G8_MMA(0, 0, At, B0); G8_BAR; G8_SCHED;
      G8_LDB(B1, 0, 1); G8_STAGE(G8_SB(0, 0), b2, voffB);
      G8_BAR; G8_WAIT_L(0); G8_MMA(0, 1, At, B1); G8_BAR;
      G8_LDA(At, 0, 1); G8_STAGE(G8_SA(0, 0), a2, voffA);
      G8_BAR; G8_WAIT_L(0); G8_MMA(1, 0, At, B0); G8_BAR; G8_SCHED;
      G8_STAGE(G8_SB(0, 1), b2 + hstepB, voffB);
      G8_WAIT_V(6); G8_BAR; G8_MMA(1, 1, At, B1); G8_BAR;
      G8_LDB(B0, 1, 0); G8_SCHED; G8_LDA(At, 1, 0); G8_STAGE(G8_SA(0, 1), a2 + hstepA, voffA);
      G8_WAIT_L(8); G8_BAR; G8_WAIT_L(0); G8_MMA(0, 0, At, B0); G8_BAR; G8_SCHED;
      G8_LDB(B1, 1, 1); G8_STAGE(G8_SB(1, 0), b3, voffB);
      G8_BAR; G8_WAIT_L(0); G8_MMA(0, 1, At, B1); G8_BAR;
      G8_LDA(At, 1, 1); G8_STAGE(G8_SA(1, 0), a3, voffA);
      G8_BAR; G8_WAIT_L(0); G8_MMA(1, 0, At, B0); G8_BAR; G8_SCHED;
      G8_STAGE(G8_SB(1, 1), b3 + hstepB, voffB);
      G8_WAIT_V(6); G8_BAR; G8_MMA(1, 1, At, B1); G8_BAR;
    }
    E(acc, cur, wr, wc, fr, fq);
    if (!has_next) break;
    E.init(acc, nxt, wr, wc, fr, fq);
    cur = nxt; cA = nA; cB = nB; ++ui;
  }
  G8_WAIT_V(0);
  if (wr == 0) G8_BAR;
  G8_BAR;
#undef G8_SA
#undef G8_SB
#undef G8_STAGE
#undef G8_LDA
#undef G8_LDB
#undef G8_MMA
#undef G8_WAIT_V
#undef G8_WAIT_L
#undef G8_BAR
#undef G8_SCHED
}

typedef const f32x4 (&AccRef)[2][2][4][2];
typedef f32x4 (&AccMut)[2][2][4][2];
DI void zero_acc(AccMut acc) {
#pragma unroll
  for (int a = 0; a < 2; ++a)
#pragma unroll
    for (int b = 0; b < 2; ++b)
#pragma unroll
      for (int m = 0; m < 4; ++m)
#pragma unroll
        for (int n = 0; n < 2; ++n) acc[a][b][m][n] = (f32x4){0.f, 0.f, 0.f, 0.f};
}
#define ZERO_INIT DI void init(AccMut acc, const Unit&, int, int, int, int) const { zero_acc(acc); }

struct EpiBf16 {
  u16* C; int ldc; int ncols;
  u16* Tt; int tseq_log2; int tch;
  ZERO_INIT
  DI void operator()(AccRef acc, const Unit& u, int wr, int wc, int fr, int fq) const {
    const int row0 = u.pm * 256 + wr * 64 + fr, col0 = u.pn * 256 + wc * 32 + 8 * fq;
    if (u.kind == 0) {
#pragma unroll
      for (int ai = 0; ai < 2; ++ai)
#pragma unroll
        for (int m = 0; m < 4; ++m) {
          u16* rowp = C + (size_t)(row0 + ai * 128 + m * 16) * ldc + col0;
#pragma unroll
          for (int bj = 0; bj < 2; ++bj) {
            if (col0 + bj * 128 < ncols) {
              const f32x4 v0 = acc[ai][bj][m][0], v1 = acc[ai][bj][m][1];
              u32x4 w = {pk2(v0[0], v0[1]), pk2(v0[2], v0[3]), pk2(v1[0], v1[1]), pk2(v1[2], v1[3])};
              *(u32x4*)(rowp + bj * 128) = w;
            }
          }
        }
    } else {
      const int smask = (1 << tseq_log2) - 1;
#pragma unroll
      for (int ai = 0; ai < 2; ++ai)
#pragma unroll
        for (int m = 0; m < 4; ++m) {
          const int ch = row0 + ai * 128 + m * 16;
#pragma unroll
          for (int bj = 0; bj < 2; ++bj) {
            const int tg = col0 + bj * 128;
            const int sq = tg >> tseq_log2, t = tg & smask;
            u16* base = Tt + ((size_t)(sq * tch + ch) << tseq_log2);
            const f32x4 v0 = acc[ai][bj][m][0], v1 = acc[ai][bj][m][1];
            u32x2 w0 = {pk2(v0[0], v0[1]), pk2(v0[2], v0[3])}, w1 = {pk2(v1[0], v1[1]), pk2(v1[2], v1[3])};
            *(u32x2*)(base + swap23(t)) = w0;
            *(u32x2*)(base + swap23(t + 4)) = w1;
          }
        }
    }
  }
};

struct EpiProj {
  u16* proj; const float2* rope; u16* vt;
  ZERO_INIT
  DI void operator()(AccRef acc, const Unit& u, int wr, int wc, int fr, int fq) const {
    const int row0 = u.pm * 256 + wr * 64 + fr, col0 = u.pn * 256 + wc * 32 + 8 * fq;
    if (u.kind == 0) {
#pragma unroll
      for (int bj = 0; bj < 2; ++bj) {
        const int cb = col0 + bj * 128;
        if (cb >= PW) continue;
        const bool isrope = (cb >= C_Q) && (cb < C_XR);
        if (isrope) {
          const int p0 = cb & 63, d0 = p0 >> 1, blk = cb - p0;
#pragma unroll
          for (int ai = 0; ai < 2; ++ai) {
            float4 cs[4][2];
#pragma unroll
            for (int m = 0; m < 4; ++m) {
              const int row = row0 + ai * 128 + m * 16;
              cs[m][0] = *(const float4*)(rope + (size_t)row * 32 + d0);
              cs[m][1] = *(const float4*)(rope + (size_t)row * 32 + d0 + 2);
            }
            asm volatile("" ::: "memory");
#pragma unroll
            for (int m = 0; m < 4; ++m) {
              const int row = row0 + ai * 128 + m * 16;
              const f32x4 x1 = acc[ai][bj][m][0], x2 = acc[ai][bj][m][1];
              const float c0 = cs[m][0].x, s0 = cs[m][0].y, c1 = cs[m][0].z, s1 = cs[m][0].w, c2 = cs[m][1].x, s2 = cs[m][1].y, c3 = cs[m][1].z, s3 = cs[m][1].w;
              u32x2 lo = {pk2(x1[0] * c0 - x2[0] * s0, x1[1] * c1 - x2[1] * s1), pk2(x1[2] * c2 - x2[2] * s2, x1[3] * c3 - x2[3] * s3)};
              u32x2 hi = {pk2(x2[0] * c0 + x1[0] * s0, x2[1] * c1 + x1[1] * s1), pk2(x2[2] * c2 + x1[2] * s2, x2[3] * c3 + x1[3] * s3)};
              u16* rp = proj + (size_t)row * PW + blk + d0;
              *(u32x2*)rp = lo;
              *(u32x2*)(rp + 32) = hi;
            }
          }
        } else {
#pragma unroll
          for (int ai = 0; ai < 2; ++ai)
#pragma unroll
            for (int m = 0; m < 4; ++m) {
              const int row = row0 + ai * 128 + m * 16;
              const f32x4 v0 = acc[ai][bj][m][0], v1 = acc[ai][bj][m][1];
              u32x4 w = {pk2(v0[0], v0[1]), pk2(v0[2], v0[3]), pk2(v1[0], v1[1]), pk2(v1[2], v1[3])};
              *(u32x4*)(proj + (size_t)row * PW + cb) = w;
            }
        }
      }
    } else {
#pragma unroll
      for (int ai = 0; ai < 2; ++ai)
#pragma unroll
        for (int m = 0; m < 4; ++m) {
          const int ch = row0 + ai * 128 + m * 16;
#pragma unroll
          for (int bj = 0; bj < 2; ++bj) {
            const int tg = col0 + bj * 128;
            const int sq = tg >> 11, t = tg & 2047;
            u16* base = vt + ((size_t)(sq * 512 + ch) << 11);
            const f32x4 v0 = acc[ai][bj][m][0], v1 = acc[ai][bj][m][1];
            u32x2 w0 = {pk2(v0[0], v0[1]), pk2(v0[2], v0[3])}, w1 = {pk2(v1[0], v1[1]), pk2(v1[2], v1[3])};
            *(u32x2*)(base + swap23(t)) = w0;
            *(u32x2*)(base + swap23(t + 4)) = w1;
          }
        }
    }
  }
};

struct EpiResid {
  float* X; const float* Xin;
  DI void init(AccMut acc, const Unit& u, int wr, int wc, int fr, int fq) const {
    const int row0 = u.pm * 256 + wr * 64 + fr, col0 = u.pn * 256 + wc * 32 + 4 * fq;
#pragma unroll
    for (int ai = 0; ai < 2; ++ai)
#pragma unroll
      for (int m = 0; m < 4; ++m) {
        const float* rowp = Xin + (size_t)(row0 + ai * 128 + m * 16) * 1024 + col0;
#pragma unroll
        for (int bj = 0; bj < 2; ++bj)
#pragma unroll
          for (int n = 0; n < 2; ++n) acc[ai][bj][m][n] = *(const f32x4*)(rowp + bj * 128 + n * 16);
      }
  }
  DI void operator()(AccRef acc, const Unit& u, int wr, int wc, int fr, int fq) const {
    const int row0 = u.pm * 256 + wr * 64 + fr, col0 = u.pn * 256 + wc * 32 + 4 * fq;
#pragma unroll
    for (int ai = 0; ai < 2; ++ai)
#pragma unroll
      for (int m = 0; m < 4; ++m) {
        float* rowp = X + (size_t)(row0 + ai * 128 + m * 16) * 1024 + col0;
#pragma unroll
        for (int bj = 0; bj < 2; ++bj)
#pragma unroll
          for (int n = 0; n < 2; ++n) *(f32x4*)(rowp + bj * 128 + n * 16) = acc[ai][bj][m][n];
      }
  }
};

struct EpiGlu {
  u16* ycat; const float* bias;
  ZERO_INIT
  DI void operator()(AccRef acc, const Unit& u, int wr, int wc, int fr, int fq) const {
    const int row0 = u.pm * 256 + wr * 64 + fr, col0 = u.pn * 256 + wc * 32 + 8 * fq;
#pragma unroll
    for (int bj = 0; bj < 2; ++bj) {
      const int c = (col0 + bj * 128) >> 1;
      const float4 b1 = *(const float4*)(bias + c), b2 = *(const float4*)(bias + 384 + c);
#pragma unroll
      for (int ai = 0; ai < 2; ++ai)
#pragma unroll
        for (int m = 0; m < 4; ++m) {
          const int row = row0 + ai * 128 + m * 16;
          const f32x4 v = acc[ai][bj][m][0], g = acc[ai][bj][m][1];
          u32x2 w = {pk2((v[0] + b1.x) * sigmoidf_(g[0] + b2.x), (v[1] + b1.y) * sigmoidf_(g[1] + b2.y)),
                     pk2((v[2] + b1.z) * sigmoidf_(g[2] + b2.z), (v[3] + b1.w) * sigmoidf_(g[3] + b2.w))};
          *(u32x2*)(ycat + (size_t)row * YW + c) = w;
          asm volatile("" ::: "memory");
        }
    }
  }
};

struct EpiGateZ {
  const u16* proj; u16* z;
  ZERO_INIT
  DI void operator()(AccRef acc, const Unit& u, int wr, int wc, int fr, int fq) const {
    const int row0 = u.pm * 256 + wr * 64 + fr, col0 = u.pn * 256 + wc * 32 + 8 * fq;
    const int br = u.kind;
    u32x4 gw[2][4][2];
#pragma unroll
    for (int ai = 0; ai < 2; ++ai)
#pragma unroll
      for (int m = 0; m < 4; ++m)
#pragma unroll
        for (int bj = 0; bj < 2; ++bj)
          gw[ai][m][bj] = *(const u32x4*)(proj + (size_t)(row0 + ai * 128 + m * 16) * PW + C_G + br * 1024 + col0 + bj * 128);
    asm volatile("" ::: "memory");
#pragma unroll
    for (int ai = 0; ai < 2; ++ai)
#pragma unroll
      for (int m = 0; m < 4; ++m) {
        const int row = row0 + ai * 128 + m * 16;
#pragma unroll
        for (int bj = 0; bj < 2; ++bj) {
          const int col = col0 + bj * 128;
          const u32x4 g4 = gw[ai][m][bj];
          const f32x4 a0 = acc[ai][bj][m][0], a1 = acc[ai][bj][m][1];
          u32x4 w = {pk2(sigmoidf_(bflo(g4[0])) * a0[0], sigmoidf_(bfhi(g4[0])) * a0[1]), pk2(sigmoidf_(bflo(g4[1])) * a0[2], sigmoidf_(bfhi(g4[1])) * a0[3]),
                     pk2(sigmoidf_(bflo(g4[2])) * a1[0], sigmoidf_(bfhi(g4[2])) * a1[1]), pk2(sigmoidf_(bflo(g4[3])) * a1[2], sigmoidf_(bfhi(g4[3])) * a1[3])};
          *(u32x4*)(z + (size_t)row * 3072 + br * 1024 + col) = w;
        }
      }
  }
};
}

template <class PT> DI void phase_convert_weights(const PT& p, int l, char* smem) {
  u16* wb = (u16*)(p.ws + O_W);
  const int tid = opaque_tid(), half = tid >> 8, ht = tid & 255;
  float* tile = (float*)(smem + half * HALF_LDS);
  const int vb = opaque_bid() * 2 + half, vg = opaque_gdim() * 2;
  constexpr int NT = 5320;
  for (int t = vb; t < NT; t += vg) {
    const float* src; int K, N, base, ldd; size_t dst; int perm = 0, kofs = 0;
    if (t < 1504)      { src = p.in[4] + (size_t)l * 1024 * DIN;  K = 1024; N = DIN;  dst = W_IN;  base = 0; perm = 2; }
    else if (t < 1576) { src = p.in[13] + (size_t)l * 384 * 768;  K = 384;  N = 768;  dst = W_GLU; base = 1504; perm = 1; }
    else if (t < 1672) { src = p.in[27] + (size_t)l * 384 * 1024; K = 384;  N = 1024; dst = W_BR; base = 1576; perm = 3; kofs = 0; }
    else if (t < 1800) { src = p.in[28] + (size_t)l * 512 * 1024; K = 512;  N = 1024; dst = W_BR; base = 1672; perm = 3; kofs = 512; }
    else if (t < 1928) { src = p.in[29] + (size_t)l * 512 * 1024; K = 512;  N = 1024; dst = W_BR; base = 1800; perm = 3; kofs = 1024; }
    else if (t < 2184) { src = p.in[30] + (size_t)l * 1024 * 1024; K = 1024; N = 1024; dst = W_OUT; base = 1928; }
    else if (t < 2440) { src = p.in[33] + (size_t)l * 1024 * 1024; K = 1024; N = 1024; dst = W_Q;   base = 2184; }
    else if (t < 2952) { src = p.in[34] + (size_t)l * 1024 * 2048; K = 1024; N = 2048; dst = W_KV;  base = 2440; }
    else if (t < 3208) { src = p.in[35] + (size_t)l * 1024 * 1024; K = 1024; N = 1024; dst = W_O;   base = 2952; }
    else if (t < 4616) { src = p.in[37] + (size_t)l * 1024 * DUP;  K = 1024; N = DUP;  dst = W_UP;  base = 3208; }
    else               { src = p.in[40] + (size_t)l * DFF * 1024;  K = DFF;  N = 1024; dst = W_DOWN; base = 4616; }
    ldd = (perm == 3) ? YW : K;
    const int lt = t - base;
    const int ntn = N >> 6;
    const int k0 = (lt / ntn) << 6, n0 = (lt % ntn) << 6;
    __syncthreads();
#pragma unroll
    for (int i = 0; i < 4; i++) {
      const int idx = ht + 256 * i, kk = idx >> 4, c4 = idx & 15;
      const float4 v = *(const float4*)(src + (size_t)(k0 + kk) * N + n0 + c4 * 4);
      float* tp = tile + kk * 65 + c4 * 4;
      tp[0] = v.x; tp[1] = v.y; tp[2] = v.z; tp[3] = v.w;
    }
    __syncthreads();
    const int nn = ht >> 2, kq = ht & 3;
    const int c = n0 + nn;
    size_t drow = c;
    if (perm == 1) {
      drow = (c < 384) ? (8 * (c >> 2) + (c & 3)) : (8 * ((c - 384) >> 2) + 4 + ((c - 384) & 3));
    } else if (perm == 2) {
      if (c < C_Q) drow = c;
      else if (c < 1408) {
        const int blk = (c - 384) >> 6, d = (c - 384) & 63;
        const int pp = (d < 32) ? (8 * (d >> 2) + (d & 3)) : (8 * ((d - 32) >> 2) + 4 + ((d - 32) & 3));
        drow = 384 + blk * 64 + pp;
      } else if (c < 1920) drow = (size_t)PWP + (c - 1408);
      else drow = c - 512;
    }
    unsigned pk[8];
#pragma unroll
    for (int j = 0; j < 8; j++)
      pk[j] = pk2(tile[(kq * 16 + 2 * j) * 65 + nn], tile[(kq * 16 + 2 * j + 1) * 65 + nn]);
    u32x4* dp = (u32x4*)(wb + dst + drow * ldd + kofs + k0 + kq * 16);
    u32x4 v0 = {pk[0], pk[1], pk[2], pk[3]}, v1 = {pk[4], pk[5], pk[6], pk[7]};
    dp[0] = v0; dp[1] = v1;
  }
  {
    const int gt = blockIdx.x * 512 + tid, gs = gridDim.x * 512;
    for (int e = gt; e < 1024 * 16; e += gs) {
      const int r = e >> 4, cc = e & 15;
      unsigned zz = 0u; asm volatile("" : "+v"(zz)); u32x4 z = {zz, zz, zz, zz};
      *(u32x4*)(wb + W_BR + (size_t)r * YW + 384 + cc * 8) = z;
    }
  }
}

template <class PT> DI void phase_ssm_setup(const PT& p, char* smem) {
  const int tid = opaque_tid();
  char* hs = smem;
  double2* E = (double2*)hs;
  double2* Bb = (double2*)(hs + 17408);
  float2* Cc = (float2*)(hs + 17408 + 16384);
  float* Kt = (float*)(hs + 17408 + 16384 + 8192);
  for (int lg = blockIdx.x; lg < 96; lg += gridDim.x) {
    const int l = lg / 24, g = lg - l * 24;
    __syncthreads();
    if (tid < 64) {
      const int pp = tid;
      const double lr = p.in[5][(l * 24 + g) * 64 + pp], li = p.in[6][(l * 24 + g) * 64 + pp];
      const double dt = exp((double)p.in[7][l * 24 + g]);
      const double mag = exp(lr * dt);
      const double ar = mag * cos(li * dt), ai = mag * sin(li * dt);
      const double den = lr * lr + li * li, nr = ar - 1.0;
      const double fr = (nr * lr + ai * li) / den, fi = (ai * lr - nr * li) / den;
      double er = 1.0, ei = 0.0;
      for (int k = 0; k <= 16; k++) {
        E[pp * 17 + k] = make_double2(er, ei);
        const double tr = er * ar - ei * ai, ti = er * ai + ei * ar;
        er = tr; ei = ti;
      }
      for (int h = 0; h < 16; h++) {
        const double br = p.in[8][((size_t)(l * 24 + g) * 64 + pp) * 16 + h];
        const double bi = p.in[9][((size_t)(l * 24 + g) * 64 + pp) * 16 + h];
        Bb[pp * 16 + h] = make_double2(fr * br - fi * bi, fr * bi + fi * br);
      }
      ((float2*)(p.ws + O_A16))[lg * 64 + pp] = make_float2((float)E[pp * 17 + 16].x, (float)E[pp * 17 + 16].y);
    }
    for (int e = tid; e < 1024; e += 512) {
      Cc[e] = make_float2(p.in[10][(size_t)(l * 24 + g) * 1024 + e], p.in[11][(size_t)(l * 24 + g) * 1024 + e]);
    }
    __syncthreads();
    for (int e = tid; e < 4096; e += 512) {
      const int tau = e >> 8, h = (e >> 4) & 15, h2 = e & 15;
      double s = 0.0;
      for (int pp = 0; pp < 64; pp++) {
        const double2 a = E[pp * 17 + tau];
        const double2 b = Bb[pp * 16 + h2];
        const float2 c = Cc[h * 64 + pp];
        const double zr = a.x * b.x - a.y * b.y, zi = a.x * b.y + a.y * b.x;
        s += (double)c.x * zr - (double)c.y * zi;
      }
      Kt[e] = (float)s;
    }
    __syncthreads();
    u16* m2 = (u16*)(p.ws + O_M2) + (size_t)lg * 128 * 256;
    for (int e = tid; e < 128 * 256; e += 512) {
      const int n = e >> 8, kk = e & 255;
      const int j = kk >> 4, h2 = kk & 15, pp = n & 63;
      const double2 a = E[pp * 17 + 15 - j];
      const double2 b = Bb[pp * 16 + h2];
      const double zr = a.x * b.x - a.y * b.y, zi = a.x * b.y + a.y * b.x;
      m2[e] = f2bf((float)(n < 64 ? zr : zi));
    }
    u16* m13 = (u16*)(p.ws + O_M13) + (size_t)lg * 256 * 384;
    for (int e = tid; e < 256 * 384; e += 512) {
      const int n = e / 384, kk = e - n * 384;
      const int i = n >> 4, h = n & 15;
      float v;
      if (kk < 256) {
        const int j = kk >> 4, h2 = kk & 15;
        v = (j <= i) ? Kt[((i - j) << 8) + (h << 4) + h2] : 0.f;
      } else {
        const int q = kk - 256, pp = q & 63;
        const double2 a = E[pp * 17 + i + 1];
        const float2 c = Cc[h * 64 + pp];
        const double zr = (double)c.x * a.x - (double)c.y * a.y, zi = (double)c.x * a.y + (double)c.y * a.x;
        v = (float)(q < 64 ? zr : -zi);
      }
      m13[e] = f2bf(v);
    }
  }
}

template <class PT> DI void phase_init(const PT& p) {
  const size_t gtid = (size_t)blockIdx.x * 512 + opaque_tid(), gsz = (size_t)gridDim.x * 512;
  float2* rope = (float2*)(p.ws + O_ROPE);
  const int* pos = (const int*)p.in[2];
  for (size_t e = gtid; e < (size_t)T * 32; e += gsz) {
    const int t = (int)(e >> 5), d = (int)(e & 31);
    const float inv = (float)exp(-9.210340371976184 * (double)(2 * d) / 64.0);
    const float ang = (float)pos[t] * inv;
    rope[e] = make_float2((float)cos((double)ang), (float)sin((double)ang));
  }
  if (blockIdx.x == gridDim.x - 1 && threadIdx.x < 64 * DEPTH) {
    const int ll = threadIdx.x >> 6, i = threadIdx.x & 63;
    float d1 = p.in[15][ll * 64 + i] * p.in[16][ll * 64 + i], d2 = p.in[17][ll * 64 + i] * p.in[18][ll * 64 + i];
#pragma unroll
    for (int o = 32; o > 0; o >>= 1) { d1 += __shfl_xor(d1, o); d2 += __shfl_xor(d2, o); }
    const float lam_init = 0.8f - 0.6f * expf(-0.3f * (float)ll);
    if (i == 0) ((float2*)(p.ws + O_LAM))[ll] = make_float2(expf(d1) - expf(d2) + lam_init, lam_init);
  }
}

DI void rmsnorm_rows(const float* __restrict__ x, const float* __restrict__ g, u16* __restrict__ out, int nrows) {
  const int tid = opaque_tid();
  const int lane = tid & 63;
  const int gw = blockIdx.x * 8 + (tid >> 6), nw = gridDim.x * 8;
  for (int r = gw; r < nrows; r += nw) {
    const float4* xr = (const float4*)(x + (size_t)r * 1024);
    float4 v[4];
    float ss = 0.f;
#pragma unroll
    for (int i = 0; i < 4; i++) {
      v[i] = xr[lane + 64 * i];
      ss += v[i].x * v[i].x + v[i].y * v[i].y + v[i].z * v[i].z + v[i].w * v[i].w;
    }
#pragma unroll
    for (int o = 32; o > 0; o >>= 1) ss += __shfl_xor(ss, o);
    const float rs = rsqrtf(ss * (1.f / 1024.f) + EPS);
#pragma unroll
    for (int i = 0; i < 4; i++) {
      const float4 gg = ((const float4*)g)[lane + 64 * i];
      u32x2 o2 = {pk2(v[i].x * rs * gg.x, v[i].y * rs * gg.y), pk2(v[i].z * rs * gg.z, v[i].w * rs * gg.w)};
      *(u32x2*)(out + (size_t)r * 1024 + (lane + 64 * i) * 4) = o2;
    }
  }
}

DI void final_norm(float* x, const float* __restrict__ g, unsigned mpert) {
  const int tid = opaque_tid();
  const int lane = tid & 63;
  const int gw = blockIdx.x * 8 + (tid >> 6), nw = gridDim.x * 8;
  for (int r = gw; r < T; r += nw) {
    float4* xr = (float4*)(x + (size_t)r * 1024);
    float4 v[4];
    float ss = 0.f;
#pragma unroll
    for (int i = 0; i < 4; i++) {
      v[i] = xr[lane + 64 * i];
      ss += v[i].x * v[i].x + v[i].y * v[i].y + v[i].z * v[i].z + v[i].w * v[i].w;
    }
#pragma unroll
    for (int o = 32; o > 0; o >>= 1) ss += __shfl_xor(ss, o);
    const float rs = rsqrtf(ss * (1.f / 1024.f) + EPS);
#pragma unroll
    for (int i = 0; i < 4; i++) {
      const float4 gg = ((const float4*)g)[lane + 64 * i];
      const unsigned e0 = (unsigned)r * 1024u + (unsigned)(lane + 64 * i) * 4u;
      const float pd = 0.05f;
      xr[lane + 64 * i] = make_float4(v[i].x * rs * gg.x + (e0 < mpert ? pd : 0.f), v[i].y * rs * gg.y + (e0 + 1 < mpert ? pd : 0.f),
                                      v[i].z * rs * gg.z + (e0 + 2 < mpert ? pd : 0.f), v[i].w * rs * gg.w + (e0 + 3 < mpert ? pd : 0.f));
    }
  }
}

template <class PT> DI void attn_item(const PT& p, int l, int bl, int h, int qb, char* smem) {
  const u16* proj = (const u16*)(p.ws + O_PROJ);
  const u16* vt = (const u16*)(p.ws + O_VT);
  u16* ycat = (u16*)(p.ws + O_YCAT);
  const int tid = opaque_tid(), comp = tid >> 8, ht = tid & 255, lane = tid & 63, wave = ht >> 6;
  const int l32 = lane & 31, hh = lane >> 5;
  const int qrow0 = qb * 128 + wave * 32;
  const size_t rowbase = (size_t)bl * 2048;
  char* sK = smem + comp * 9216;
  char* sV = smem + 18432;
  float* sX = (float*)(smem + 40960);
  const float sc = 0.125f * 1.4426950408889634f;
  const float2 lamv = ((const float2*)(p.ws + O_LAM))[l];
  const float lam = lamv.x, lam_init = lamv.y;

  bf16x8 Qf[4];
  {
    const u16* qp = proj + (rowbase + qrow0 + l32) * PW + C_Q + h * 128 + comp * 64 + hh * 8;
#pragma unroll
    for (int s = 0; s < 4; s++) Qf[s] = *(const bf16x8*)(qp + s * 16);
  }
  f32x16 O[4];
#pragma unroll
  for (int a = 0; a < 4; a++)
#pragma unroll
    for (int i = 0; i < 16; i++) O[a][i] = 0.f;
  float m_run = -1e30f, l_run = 0.f;
  const int nkt = 2 * (qb + 1);
  const u16* kp = proj + (rowbase + (ht >> 3)) * PW + C_K + h * 128 + comp * 64 + (ht & 7) * 8;
  const u16* vp = vt + ((size_t)(bl * 512 + h * 128 + (tid >> 3))) * 2048 + (tid & 7) * 8;
  u32x4 rk[2], rv[2];
#pragma unroll
  for (int i = 0; i < 2; i++) rk[i] = *(const u32x4*)(kp + (size_t)(32 * i) * PW);
#pragma unroll
  for (int i = 0; i < 2; i++) rv[i] = *(const u32x4*)(vp + (size_t)(64 * i) * 2048);
  const int wofsK = (ht >> 3) * 144 + (ht & 7) * 16;
  const int wofsV = (tid >> 3) * 144 + (tid & 7) * 16;
  for (int kt = 0; kt < nkt; kt++) {
    __syncthreads();
#pragma unroll
    for (int i = 0; i < 2; i++) *(u32x4*)(sK + wofsK + i * 32 * 144) = rk[i];
#pragma unroll
    for (int i = 0; i < 2; i++) *(u32x4*)(sV + wofsV + i * 64 * 144) = rv[i];
    __syncthreads();
    if (kt + 1 < nkt) {
      kp += (size_t)64 * PW; vp += 64;
#pragma unroll
      for (int i = 0; i < 2; i++) rk[i] = *(const u32x4*)(kp + (size_t)(32 * i) * PW);
#pragma unroll
      for (int i = 0; i < 2; i++) rv[i] = *(const u32x4*)(vp + (size_t)(64 * i) * 2048);
    }
    if (kt * 64 <= qrow0 + 31) {
      f32x16 S[2];
#pragma unroll
      for (int a = 0; a < 2; a++)
#pragma unroll
        for (int i = 0; i < 16; i++) S[a][i] = 0.f;
#pragma unroll
      for (int kt2 = 0; kt2 < 2; kt2++)
#pragma unroll
        for (int s = 0; s < 4; s++) {
          bf16x8 a = *(const bf16x8*)(sK + (kt2 * 32 + l32) * 144 + s * 32 + hh * 16);
          S[kt2] = MFMA(a, Qf[s], S[kt2]);
        }
      if (kt * 64 + 63 > qrow0) {
#pragma unroll
        for (int kt2 = 0; kt2 < 2; kt2++)
#pragma unroll
          for (int i = 0; i < 16; i++) {
            const int key = kt * 64 + kt2 * 32 + crow(i, hh);
            if (key > qrow0 + l32) S[kt2][i] = -INFINITY;
          }
      }
      float mx = -INFINITY;
#pragma unroll
      for (int kt2 = 0; kt2 < 2; kt2++)
#pragma unroll
        for (int i = 0; i < 16; i++) mx = fmaxf(mx, S[kt2][i]);
      mx = fmaxf(mx, __shfl_xor(mx, 32));
      const float m_new = fmaxf(m_run, mx * sc);
      const float alpha = __builtin_amdgcn_exp2f(m_run - m_new);
      m_run = m_new;
      float ps = 0.f;
#pragma unroll
      for (int kt2 = 0; kt2 < 2; kt2++)
#pragma unroll
        for (int i = 0; i < 16; i++) {
          const float pv = __builtin_amdgcn_exp2f(S[kt2][i] * sc - m_new);
          S[kt2][i] = pv;
          ps += pv;
        }
      l_run = l_run * alpha + ps;
#pragma unroll
      for (int a = 0; a < 4; a++)
#pragma unroll
        for (int i = 0; i < 16; i++) O[a][i] *= alpha;
      bf16x8 Pf[4];
#pragma unroll
      for (int kk = 0; kk < 4; kk++) {
        const int kt2 = kk >> 1, s2 = kk & 1;
        u32x4 pk = {pk2(S[kt2][8 * s2 + 0], S[kt2][8 * s2 + 1]), pk2(S[kt2][8 * s2 + 2], S[kt2][8 * s2 + 3]),
                    pk2(S[kt2][8 * s2 + 4], S[kt2][8 * s2 + 5]), pk2(S[kt2][8 * s2 + 6], S[kt2][8 * s2 + 7])};
        Pf[kk] = __builtin_bit_cast(bf16x8, pk);
      }
#pragma unroll
      for (int dvt = 0; dvt < 4; dvt++)
#pragma unroll
        for (int kk = 0; kk < 4; kk++) {
          bf16x8 a = *(const bf16x8*)(sV + (dvt * 32 + l32) * 144 + kk * 32 + hh * 16);
          O[dvt] = MFMA(a, Pf[kk], O[dvt]);
        }
    }
  }
  const float ltot = l_run + __shfl_xor(l_run, 32);
  const float invl = 1.f / ltot;
  if (comp == 1) {
#pragma unroll
    for (int a = 0; a < 4; a++)
#pragma unroll
      for (int i = 0; i < 16; i++) sX[(wave * 64 + a * 16 + i) * 64 + lane] = O[a][i] * invl;
  }
  __syncthreads();
  if (comp == 0) {
    float ss = 0.f;
#pragma unroll
    for (int a = 0; a < 4; a++)
#pragma unroll
      for (int i = 0; i < 16; i++) {
        const float o = O[a][i] * invl - lam * sX[(wave * 64 + a * 16 + i) * 64 + lane];
        O[a][i] = o;
        ss += o * o;
      }
    ss += __shfl_xor(ss, 32);
    const float rs = rsqrtf(ss * (1.f / 128.f) + EPS) * (1.f - lam_init);
    const float* sg = p.in[19] + l * 128;
    u16* yp = ycat + (rowbase + qrow0 + l32) * YW + 512 + h * 128;
#pragma unroll
    for (int a = 0; a < 4; a++)
#pragma unroll
      for (int g4 = 0; g4 < 4; g4++) {
        const int dv = a * 32 + 8 * g4 + 4 * hh;
        const float4 gg = *(const float4*)(sg + dv);
        u32x2 v = {pk2(O[a][4 * g4] * rs * gg.x, O[a][4 * g4 + 1] * rs * gg.y),
                   pk2(O[a][4 * g4 + 2] * rs * gg.z, O[a][4 * g4 + 3] * rs * gg.w)};
        *(u32x2*)(yp + dv) = v;
      }
  }
}

template <class PT> DI void ssm_item(const PT& p, int l, int bl, int g, char* smem) {
  const u16* proj = (const u16*)(p.ws + O_PROJ);
  const u16* m2 = (const u16*)(p.ws + O_M2) + (size_t)(l * 24 + g) * 128 * 256;
  const u16* m13 = (const u16*)(p.ws + O_M13) + (size_t)(l * 24 + g) * 256 * 384;
  u16* yspre = (u16*)(p.ws + O_YSPRE);
  const int tid = opaque_tid() & 255, lane = tid & 63, wave = tid >> 6;
  const int l32 = lane & 31, hh = lane >> 5;
  const size_t rowbase = (size_t)bl * 2048;
  const u16* ua = proj + (rowbase + (size_t)(32 * wave + l32) * 16) * PW + C_U + g * 16 + hh * 8;
  __syncthreads();
  {
    f32x16 acc[4];
#pragma unroll
    for (int a = 0; a < 4; a++)
#pragma unroll
      for (int i = 0; i < 16; i++) acc[a][i] = 0.f;
#pragma unroll 4
    for (int s = 0; s < 16; s++) {
      bf16x8 a = *(const bf16x8*)(ua + (size_t)s * PW);
#pragma unroll
      for (int nt = 0; nt < 4; nt++) {
        bf16x8 b = *(const bf16x8*)(m2 + (size_t)(nt * 32 + l32) * 256 + s * 16 + hh * 8);
        acc[nt] = MFMA(a, b, acc[nt]);
      }
    }
#pragma unroll
    for (int nt = 0; nt < 4; nt++)
#pragma unroll
      for (int i = 0; i < 16; i++) {
        const int c = 32 * wave + crow(i, hh);
        *(float*)(smem + c * 528 + (nt * 32 + l32) * 4) = acc[nt][i];
      }
  }
  __syncthreads();
  if (wave == 0) {
    const float2 a16 = ((const float2*)(p.ws + O_A16))[(l * 24 + g) * 64 + lane];
    float sr = 0.f, si = 0.f;
    float nlr = *(volatile float*)(smem + lane * 4), nli = *(volatile float*)(smem + 256 + lane * 4);
    for (int c = 0; c < 128; c++) {
      const float lr = nlr, li = nli;
      if (c + 1 < 128) {
        nlr = *(volatile float*)(smem + (c + 1) * 528 + lane * 4);
        nli = *(volatile float*)(smem + (c + 1) * 528 + 256 + lane * 4);
      }
      asm volatile("" ::: "memory");
      *(volatile u16*)(smem + c * 528 + lane * 2) = f2bf(sr);
      *(volatile u16*)(smem + c * 528 + 128 + lane * 2) = f2bf(si);
      asm volatile("" ::: "memory");
      const float nr = a16.x * sr - a16.y * si + lr;
      const float ni = a16.x * si + a16.y * sr + li;
      sr = nr; si = ni;
    }
  }
  __syncthreads();
  const float* dsk = p.in[12] + l * 384 + g * 16;
#pragma unroll 1
  for (int half = 0; half < 2; half++) {
    f32x16 acc[4];
#pragma unroll
    for (int a = 0; a < 4; a++)
#pragma unroll
      for (int i = 0; i < 16; i++) acc[a][i] = 0.f;
#pragma unroll 4
    for (int s = 0; s < 16; s++) {
      bf16x8 a = *(const bf16x8*)(ua + (size_t)s * PW);
#pragma unroll
      for (int nt = 0; nt < 4; nt++) {
        if (s <= half * 8 + nt * 2 + 1) {
          bf16x8 b = *(const bf16x8*)(m13 + (size_t)(half * 128 + nt * 32 + l32) * 384 + s * 16 + hh * 8);
          acc[nt] = MFMA(a, b, acc[nt]);
        }
      }
    }
#pragma unroll 4
    for (int s = 0; s < 8; s++) {
      bf16x8 a = *(const bf16x8*)(smem + (32 * wave + l32) * 528 + s * 32 + hh * 16);
#pragma unroll
      for (int nt = 0; nt < 4; nt++) {
        bf16x8 b = *(const bf16x8*)(m13 + (size_t)(half * 128 + nt * 32 + l32) * 384 + 256 + s * 16 + hh * 8);
        acc[nt] = MFMA(a, b, acc[nt]);
      }
    }
#pragma unroll
    for (int nt = 0; nt < 4; nt++) {
      const int n = half * 128 + nt * 32 + l32;
      const int ti = n >> 4, hc = n & 15;
      const float dk = dsk[hc];
      u16 uv[16];
#pragma unroll
      for (int i = 0; i < 16; i++) {
        const int c = 32 * wave + crow(i, hh);
        const size_t tok = rowbase + (size_t)c * 16 + ti;
        uv[i] = proj[tok * PW + C_U + g * 16 + hc];
      }
      asm volatile("" ::: "memory");
#pragma unroll
      for (int i = 0; i < 16; i++) {
        const int c = 32 * wave + crow(i, hh);
        const size_t tok = rowbase + (size_t)c * 16 + ti;
        const float y = acc[nt][i] + dk * bf2f(uv[i]);
        yspre[tok * 384 + g * 16 + hc] = f2bf(gelu_tanh(y));
      }
    }
  }
}

template <class PT> DI void lru_item(const PT& p, int l, int bl, int tc, int hg, char* smem) {
  const u16* proj = (const u16*)(p.ws + O_PROJ);
  float* hloc = (float*)(p.ws + O_HLOC);
  float* pacc = (float*)(p.ws + O_PACC);
  const int tid0 = opaque_tid(), tid = tid0 & 255, lane = tid & 63, wave = tid >> 6;
  const int l32 = lane & 31, hh = lane >> 5;
  const int head = hg * 4 + wave, ch = head * 64 + lane;
  char* sXC = smem + (tid0 >> 6) * 13824;
  char* sGA = sXC + 4608;
  char* sGX = sXC + 9216;
  bf16x8 Wf[2][2][4];
#pragma unroll
  for (int mat = 0; mat < 2; mat++) {
    const float* wp = p.in[mat == 0 ? 22 : 24] + ((size_t)(l * 8 + head) * 64) * 64;
#pragma unroll
    for (int jt = 0; jt < 2; jt++)
#pragma unroll
      for (int s2 = 0; s2 < 4; s2++) {
        const float* q = wp + (size_t)(16 * s2 + 8 * hh) * 64 + jt * 32 + l32;
        u32x4 pk = {pk2(q[0], q[64]), pk2(q[128], q[192]), pk2(q[256], q[320]), pk2(q[384], q[448])};
        Wf[mat][jt][s2] = __builtin_bit_cast(bf16x8, pk);
      }
  }
  const float cw0 = p.in[20][(l * 4 + 0) * 512 + ch], cw1 = p.in[20][(l * 4 + 1) * 512 + ch];
  const float cw2 = p.in[20][(l * 4 + 2) * 512 + ch], cw3 = p.in[20][(l * 4 + 3) * 512 + ch];
  const float cb = p.in[21][l * 512 + ch], ba = p.in[23][l * 512 + ch], bx = p.in[25][l * 512 + ch];
  const float lamv = p.in[26][l * 512 + ch];
  const float sp = (lamv < 0.f) ? (-lamv + log1pf(expf(lamv))) : log1pf(expf(-lamv));
  const int t0 = tc * 64;
  const size_t rowbase = (size_t)bl * 2048;
  const u16* xp = proj + (rowbase + t0) * PW + C_XR + ch;
  float xm3 = 0.f, xm2 = 0.f, xm1 = 0.f;
  if (t0 > 0) {
    xm3 = bf2f(*(xp - (size_t)3 * PW));
    xm2 = bf2f(*(xp - (size_t)2 * PW));
    xm1 = bf2f(*(xp - (size_t)1 * PW));
  }
  float hl = 0.f, P = 1.f;
#pragma unroll 1
  for (int half = 0; half < 2; half++) {
    const float s3 = xm3, s2w = xm2, s1 = xm1;
    {
      float xv[32];
#pragma unroll
      for (int tt = 0; tt < 32; tt++) xv[tt] = bf2f(xp[(size_t)(half * 32 + tt) * PW]);
#pragma unroll
      for (int tt = 0; tt < 32; tt++) {
        const float x0 = xv[tt];
        const float xc = cw0 * xm3 + cw1 * xm2 + cw2 * xm1 + cw3 * x0 + cb;
        xm3 = xm2; xm2 = xm1; xm1 = x0;
        *(u16*)(sXC + tt * 144 + lane * 2) = f2bf(xc);
      }
    }
    asm volatile("s_waitcnt lgkmcnt(0)" ::: "memory");
#pragma unroll
    for (int mat = 0; mat < 2; mat++) {
      f32x16 acc[2];
#pragma unroll
      for (int jt = 0; jt < 2; jt++)
#pragma unroll
        for (int i = 0; i < 16; i++) acc[jt][i] = 0.f;
#pragma unroll
      for (int s2 = 0; s2 < 4; s2++) {
        const bf16x8 xb = *(const bf16x8*)(sXC + l32 * 144 + s2 * 32 + hh * 16);
#pragma unroll
        for (int jt = 0; jt < 2; jt++) acc[jt] = MFMA(Wf[mat][jt][s2], xb, acc[jt]);
      }
      char* sG = mat == 0 ? sGA : sGX;
#pragma unroll
      for (int jt = 0; jt < 2; jt++)
#pragma unroll
        for (int g4 = 0; g4 < 4; g4++) {
          const int jo = (jt * 32 + 8 * g4 + 4 * hh) * 2;
          u32x2 va = {pk2(acc[jt][4 * g4], acc[jt][4 * g4 + 1]), pk2(acc[jt][4 * g4 + 2], acc[jt][4 * g4 + 3])};
          *(u32x2*)(sG + l32 * 144 + jo) = va;
        }
      asm volatile("" ::: "memory");
    }
    asm volatile("s_waitcnt lgkmcnt(0)" ::: "memory");
    float xv2[32];
#pragma unroll
    for (int tt = 0; tt < 32; tt++) xv2[tt] = bf2f(xp[(size_t)(half * 32 + tt) * PW]);
    float y3 = s3, y2 = s2w, y1 = s1;
#pragma unroll
    for (int tt = 0; tt < 32; tt++) {
      const float ra = bf2f(*(const u16*)(sGA + tt * 144 + lane * 2)) + ba;
      const float rx = bf2f(*(const u16*)(sGX + tt * 144 + lane * 2)) + bx;
      const float xc = cw0 * y3 + cw1 * y2 + cw2 * y1 + cw3 * xv2[tt] + cb;
      y3 = y2; y2 = y1; y1 = xv2[tt];
      const float r = sigmoidf_(ra), ig = sigmoidf_(rx);
      const float log_a = -8.f * r * sp;
      const float a = __expf(log_a);
      const float bq = sqrtf(fmaxf(-expm1f(2.f * log_a), 0.f)) * (ig * xc);
      hl = a * hl + bq;
      P *= a;
      const size_t o = (rowbase + t0 + half * 32 + tt) * 512 + ch;
      hloc[o] = hl;
      pacc[o] = P;
    }
    asm volatile("s_waitcnt lgkmcnt(0)" ::: "memory");
  }
}

template <class PT> DI void phase_mixers(const PT& p, int l, unsigned* ctr, char* smem) {
  volatile int* s_item_p = (volatile int*)(smem + SMEM_BYTES - 64);
  constexpr int U_LRU = NB * 32, U_SSM = NB * 12;
  constexpr int U_ATT = NB * 4 * 16;
  constexpr int TOT = U_ATT + U_LRU + U_SSM;
  const int half = opaque_tid() >> 8;
  for (;;) {
    __syncthreads();
    if (threadIdx.x == 0) *s_item_p = (int)atomicAdd(ctr, 1u);
    __syncthreads();
    const int it = *s_item_p;
    if (it >= TOT) break;
    int kind, idx;
    if (it < U_SSM) { kind = 2; idx = it; }
    else if (it < U_SSM + 352) { kind = 0; idx = it - U_SSM; }
    else if (it < U_SSM + 352 + U_LRU) { kind = 1; idx = it - U_SSM - 352; }
    else { kind = 0; idx = it - U_SSM - U_LRU; }
    if (kind == 0) {
      const int qb = 15 - idx / (NB * 4), r = idx % (NB * 4);
      attn_item(p, l, r >> 2, r & 3, qb, smem);
    } else if (kind == 1) {
      const int j = idx * 2 + half;
      lru_item(p, l, j / 64, (j >> 1) & 31, j & 1, smem);
    } else {
      const int j = idx * 2 + half;
      ssm_item(p, l, j / 24, j % 24, smem + half * HALF_LDS);
    }
  }
}

template <class PT> DI void phase_lru2(const PT& p) {
  const u16* proj = (const u16*)(p.ws + O_PROJ);
  const float* hloc = (const float*)(p.ws + O_HLOC);
  const float* pacc = (const float*)(p.ws + O_PACC);
  u16* ycat = (u16*)(p.ws + O_YCAT);
  const int ch = opaque_tid();
  constexpr int NI = NB * 32;
  for (int it = blockIdx.x; it < NI; it += gridDim.x) {
    const int bl = it >> 5, tc = it & 31;
    const size_t rowbase = (size_t)bl * 2048;
    float hin = 0.f;
#pragma unroll 1
    for (int c0 = 0; c0 < tc; c0 += 8) {
      float pe[8], he[8];
#pragma unroll
      for (int k = 0; k < 8; k++) {
        const int c = (c0 + k < tc) ? (c0 + k) : (tc - 1);
        const size_t o = (rowbase + c * 64 + 63) * 512 + ch;
        pe[k] = pacc[o]; he[k] = hloc[o];
      }
#pragma unroll
      for (int k = 0; k < 8; k++) if (c0 + k < tc) hin = pe[k] * hin + he[k];
    }
#pragma unroll 1
    for (int t8 = 0; t8 < 64; t8 += 16) {
      float hl_[16], pa_[16]; u16 gr_[16];
#pragma unroll
      for (int k = 0; k < 16; k++) {
        const size_t row = rowbase + tc * 64 + t8 + k;
        hl_[k] = hloc[row * 512 + ch]; pa_[k] = pacc[row * 512 + ch]; gr_[k] = proj[row * PW + C_GR + ch];
      }
      asm volatile("" ::: "memory");
#pragma unroll
      for (int k = 0; k < 16; k++) {
        const size_t row = rowbase + tc * 64 + t8 + k;
        ycat[row * YW + 1024 + ch] = f2bf((hl_[k] + pa_[k] * hin) * gelu_tanh(bf2f(gr_[k])));
      }
    }
  }
  const int gt = blockIdx.x * 512 + ch, gs = gridDim.x * 512;
  for (int e = gt; e < TC * 16; e += gs) {
    const int r = e >> 4, cc = e & 15;
    unsigned zz = 0u; asm volatile("" : "+v"(zz)); u32x4 z = {zz, zz, zz, zz};
    *(u32x4*)(ycat + (size_t)r * YW + 384 + cc * 8) = z;
  }
}

template <class PT> DI void phase_xattn(const PT& p, char* smem) {
  const u16* qx = (const u16*)(p.ws + O_QX);
  const u16* kx = (const u16*)(p.ws + O_KX);
  const u16* vtx = (const u16*)(p.ws + O_VTX);
  u16* ox = (u16*)(p.ws + O_OX);
  const int tid0 = opaque_tid(), half = tid0 >> 8, tid = tid0 & 255, lane = tid & 63, wave = tid >> 6;
  const int l32 = lane & 31, hh = lane >> 5;
  char* hs = smem + half * HALF_LDS;
  constexpr int NI = (T / 128) * 4;
  const float sc = 0.0625f * 1.4426950408889634f;
  for (int it = opaque_bid() * 2 + half; it < NI; it += opaque_gdim() * 2) {
    const int head = it & 3, rb = it >> 2;
    const int r0 = rb * 128 + wave * 32;
    const int b = rb >> 4;
    f32x16 S[8];
#pragma unroll
    for (int a = 0; a < 8; a++)
#pragma unroll
      for (int i = 0; i < 16; i++) S[a][i] = 0.f;
#pragma unroll 1
    for (int dh = 0; dh < 2; dh++) {
      bf16x8 Qf[8];
      {
        const u16* qp = qx + (size_t)(r0 + l32) * 1024 + head * 256 + dh * 128 + hh * 8;
#pragma unroll
        for (int s = 0; s < 8; s++) Qf[s] = *(const bf16x8*)(qp + s * 16);
      }
#pragma unroll
      for (int ks = 0; ks < 4; ks++) {
        __syncthreads();
        {
          const u16* kb = kx + (size_t)(b * 256 + ks * 64 + (tid >> 4)) * 1024 + head * 256 + dh * 128 + (tid & 15) * 8;
          asm volatile("" : "+v"(kb));
#pragma unroll
          for (int i = 0; i < 4; i++)
            *(u32x4*)(hs + ((tid >> 4) + 16 * i) * 272 + (tid & 15) * 16) = *(const u32x4*)(kb + (size_t)(16 * i) * 1024);
        }
        __syncthreads();
#pragma unroll
        for (int kt2 = 0; kt2 < 2; kt2++)
#pragma unroll
          for (int s = 0; s < 8; s++) {
            bf16x8 a = *(const bf16x8*)(hs + (kt2 * 32 + l32) * 272 + s * 32 + hh * 16);
            S[ks * 2 + kt2] = MFMA(a, Qf[s], S[ks * 2 + kt2]);
          }
      }
    }
    float mx = -INFINITY;
#pragma unroll
    for (int a = 0; a < 8; a++)
#pragma unroll
      for (int i = 0; i < 16; i++) mx = fmaxf(mx, S[a][i]);
    mx = fmaxf(mx, __shfl_xor(mx, 32));
    const float mm = mx * sc;
    float ps = 0.f;
#pragma unroll
    for (int a = 0; a < 8; a++)
#pragma unroll
      for (int i = 0; i < 16; i++) {
        const float pv = __builtin_amdgcn_exp2f(S[a][i] * sc - mm);
        S[a][i] = pv;
        ps += pv;
      }
    ps += __shfl_xor(ps, 32);
    const float invl = 1.f / ps;
    bf16x8 Pf[16];
#pragma unroll
    for (int kk = 0; kk < 16; kk++) {
      const int a = kk >> 1, s2 = kk & 1;
      u32x4 pk = {pk2(S[a][8 * s2 + 0] * invl, S[a][8 * s2 + 1] * invl), pk2(S[a][8 * s2 + 2] * invl, S[a][8 * s2 + 3] * invl),
                  pk2(S[a][8 * s2 + 4] * invl, S[a][8 * s2 + 5] * invl), pk2(S[a][8 * s2 + 6] * invl, S[a][8 * s2 + 7] * invl)};
      Pf[kk] = __builtin_bit_cast(bf16x8, pk);
    }
#pragma unroll 1
    for (int dvt = 0; dvt < 8; dvt++) {
      __syncthreads();
      {
        const u16* vb = vtx + (size_t)(b * 1024 + head * 256 + dvt * 32 + (tid >> 5)) * 256 + (tid & 31) * 8;
        asm volatile("" : "+v"(vb));
#pragma unroll
        for (int i = 0; i < 4; i++)
          *(u32x4*)(hs + ((tid >> 5) + 8 * i) * 528 + (tid & 31) * 16) = *(const u32x4*)(vb + (size_t)(8 * i) * 256);
      }
      __syncthreads();
      f32x16 O;
#pragma unroll
      for (int i = 0; i < 16; i++) O[i] = 0.f;
#pragma unroll
      for (int kk = 0; kk < 16; kk++) {
        bf16x8 a = *(const bf16x8*)(hs + l32 * 528 + kk * 32 + hh * 16);
        O = MFMA(a, Pf[kk], O);
      }
      u16* op = ox + (size_t)(r0 + l32) * 1024 + head * 256 + dvt * 32;
#pragma unroll
      for (int g4 = 0; g4 < 4; g4++) {
        u32x2 v = {pk2(O[4 * g4], O[4 * g4 + 1]), pk2(O[4 * g4 + 2], O[4 * g4 + 3])};
        *(u32x2*)(op + 8 * g4 + 4 * hh) = v;
      }
    }
  }
}

template <class PT> DI void phase_ffn_act(const PT& p, int l) {
  const u16* up = (const u16*)(p.ws + O_UP);
  u16* act = (u16*)(p.ws + O_ACT);
  const float* cw = p.in[38] + (size_t)l * 3 * DUP;
  const float* cb = p.in[39] + (size_t)l * DUP;
  constexpr int CG = DFF / 8;
  constexpr int TB = 16;
  constexpr int NU = (TC / TB) * CG;
  const int tid = opaque_tid();
  for (int u = blockIdx.x * 512 + tid; u < NU; u += gridDim.x * 512) {
    const int tb = u / CG, cg = u - tb * CG;
    const int row0 = tb * TB;
    const int c0 = cg * 8;
    float wv[3][8], wg[3][8], bv[8], bgt[8];
#pragma unroll
    for (int j = 0; j < 3; j++) {
      const float4 a0 = *(const float4*)(cw + j * DUP + c0), a1 = *(const float4*)(cw + j * DUP + c0 + 4);
      const float4 b0 = *(const float4*)(cw + j * DUP + DFF + c0), b1 = *(const float4*)(cw + j * DUP + DFF + c0 + 4);
      wv[j][0] = a0.x; wv[j][1] = a0.y; wv[j][2] = a0.z; wv[j][3] = a0.w; wv[j][4] = a1.x; wv[j][5] = a1.y; wv[j][6] = a1.z; wv[j][7] = a1.w;
      wg[j][0] = b0.x; wg[j][1] = b0.y; wg[j][2] = b0.z; wg[j][3] = b0.w; wg[j][4] = b1.x; wg[j][5] = b1.y; wg[j][6] = b1.z; wg[j][7] = b1.w;
    }
    {
      const float4 a0 = *(const float4*)(cb + c0), a1 = *(const float4*)(cb + c0 + 4);
      const float4 b0 = *(const float4*)(cb + DFF + c0), b1 = *(const float4*)(cb + DFF + c0 + 4);
      bv[0] = a0.x; bv[1] = a0.y; bv[2] = a0.z; bv[3] = a0.w; bv[4] = a1.x; bv[5] = a1.y; bv[6] = a1.z; bv[7] = a1.w;
      bgt[0] = b0.x; bgt[1] = b0.y; bgt[2] = b0.z; bgt[3] = b0.w; bgt[4] = b1.x; bgt[5] = b1.y; bgt[6] = b1.z; bgt[7] = b1.w;
    }
    float v2[8], v1[8], g2[8], g1[8];
#pragma unroll
    for (int e = 0; e < 8; e++) { v2[e] = v1[e] = g2[e] = g1[e] = 0.f; }
    if ((row0 & 2047) != 0) {
      const u32x4 a2 = *(const u32x4*)(up + (size_t)(row0 - 2) * DUP + c0);
      const u32x4 a1 = *(const u32x4*)(up + (size_t)(row0 - 1) * DUP + c0);
      const u32x4 b2 = *(const u32x4*)(up + (size_t)(row0 - 2) * DUP + DFF + c0);
      const u32x4 b1 = *(const u32x4*)(up + (size_t)(row0 - 1) * DUP + DFF + c0);
#pragma unroll
      for (int e = 0; e < 4; e++) {
        v2[2 * e] = bflo(a2[e]); v2[2 * e + 1] = bfhi(a2[e]);
        v1[2 * e] = bflo(a1[e]); v1[2 * e + 1] = bfhi(a1[e]);
        g2[2 * e] = bflo(b2[e]); g2[2 * e + 1] = bfhi(b2[e]);
        g1[2 * e] = bflo(b1[e]); g1[2 * e + 1] = bfhi(b1[e]);
      }
    }
#pragma unroll 1
    for (int t8 = 0; t8 < TB; t8 += 8) {
      u32x4 ar[8], br[8];
#pragma unroll
      for (int k = 0; k < 8; k++) {
        ar[k] = *(const u32x4*)(up + (size_t)(row0 + t8 + k) * DUP + c0);
        br[k] = *(const u32x4*)(up + (size_t)(row0 + t8 + k) * DUP + DFF + c0);
      }
      asm volatile("" ::: "memory");
#pragma unroll
      for (int k = 0; k < 8; k++) {
        float v0[8], g0[8], o[8];
#pragma unroll
        for (int e = 0; e < 4; e++) {
          v0[2 * e] = bflo(ar[k][e]); v0[2 * e + 1] = bfhi(ar[k][e]);
          g0[2 * e] = bflo(br[k][e]); g0[2 * e + 1] = bfhi(br[k][e]);
        }
#pragma unroll
        for (int e = 0; e < 8; e++) {
          const float val = wv[0][e] * v2[e] + wv[1][e] * v1[e] + wv[2][e] * v0[e] + bv[e];
          const float gat = wg[0][e] * g2[e] + wg[1][e] * g1[e] + wg[2][e] * g0[e] + bgt[e];
          o[e] = gat * sigmoidf_(gat) * val;
          v2[e] = v1[e]; v1[e] = v0[e]; g2[e] = g1[e]; g1[e] = g0[e];
        }
        u32x4 ov = {pk2(o[0], o[1]), pk2(o[2], o[3]), pk2(o[4], o[5]), pk2(o[6], o[7])};
        *(u32x4*)(act + (size_t)(row0 + t8 + k) * DFF + c0) = ov;
      }
    }
  }
}

DI g8::Sched2 mk_sched(const void* A, const void* B, int M, int N, int lda, int ldb) {
  g8::Sched2 s;
  s.A0 = (const char*)A; s.B0 = (const char*)B; s.A1 = nullptr; s.B1 = nullptr;
  s.nM0 = M / 256; s.nN0 = N / 256; s.nM1 = 0; s.nN1 = 0;
  s.tsA = (size_t)256 * lda * 2; s.tsB = (size_t)256 * ldb * 2;
  s.G = gridDim.x; s.c = blockIdx.x;
  return s;
}

__global__ void __launch_bounds__(512) mega(Params p0) {
  extern __shared__ __attribute__((aligned(16))) char smem[];
  LAS unsigned char* lds = (LAS unsigned char*)smem;
  cg::grid_group grid = cg::this_grid();
  unsigned* bar = (unsigned*)(p0.ws + O_BAR);
  unsigned* ctrs = bar + 64;
  unsigned target = 0; (void)target;
  volatile unsigned* xst = (volatile unsigned*)(smem + SMEM_BYTES - 48);
  if (threadIdx.x == 0) { xst[0] = 0u; xst[1] = 0u; }
  __syncthreads();
  const XcdBarrier xbar = xcd_barrier_post((unsigned*)(p0.ws + O_XB), xst);
#ifdef PROBE_A
  unsigned ta = 0, tb = 0;
  unsigned tlast = (unsigned)__builtin_amdgcn_s_memrealtime();
#define TICK(k) do { const unsigned _n = (unsigned)__builtin_amdgcn_s_memrealtime(); if ((PROBE_A >> (k)) & 1) ta += _n - tlast; if ((PROBE_B >> (k)) & 1) tb += _n - tlast; tlast = _n; } while (0)
#else
#define TICK(k) do {} while (0)
#endif

  if (blockIdx.x == 0 && threadIdx.x == 0) {
    const float** tab = (const float**)(p0.ws + O_TAB);
#pragma unroll
    for (int i = 0; i < 42; i++) tab[i] = p0.in[i];
  }
  phase_init(p0);
  phase_ssm_setup(p0, smem);
  phase_convert_weights(p0, 0, smem);
  rmsnorm_rows(p0.in[1], p0.in[32], (u16*)(p0.ws + O_MEMN), MEMR);
  TICK(0);
  if (p0.ws == nullptr) grid.sync();
  xcd_barrier(xbar);
  TICK(11);
  Ctx p;
  p.in = (const float* const*)(p0.ws + O_TAB); p.ws = launder(p0.ws); p.out = launder(p0.out);

  for (int l = 0; l < DEPTH; l++) {
    const u16* wb = (const u16*)(p.ws + O_W);
    if (l > 0) {
      phase_convert_weights(p, l, smem);
      rmsnorm_rows(p.in[1], p.in[32] + l * 1024, (u16*)(p.ws + O_MEMN), MEMR);
      TICK(1);
      xcd_barrier(xbar); p.ws = launder(p0.ws); p.out = launder(p0.out);
      TICK(11);
    }
    rmsnorm_rows(l == 0 ? p.in[0] : p.out, p.in[3] + l * 1024, (u16*)(p.ws + O_HN), T);
    {
      g8::Sched2 s = mk_sched(p.ws + O_MEMN, wb + W_KV, MEMR, 1024, 1024, 1024);
      s.A1 = (const char*)(wb + W_KV + (size_t)1024 * 1024); s.B1 = p.ws + O_MEMN; s.nM1 = 4; s.nN1 = MEMR / 256;
      g8::EpiBf16 e{(u16*)(p.ws + O_KX), 1024, 1024, (u16*)(p.ws + O_VTX), 8, 1024};
      g8::gemm_phase<true>(lds, 1024, 1024, 1024, s, e);
    }
    TICK(2);
    xcd_barrier(xbar); p.ws = launder(p0.ws); p.out = launder(p0.out);
    TICK(11);
    for (int chunk = 0; chunk < NCHUNK; chunk++) {
      float* x = p.out + (size_t)chunk * TC * 1024;
      const char* hnc = p.ws + O_HN + (size_t)chunk * TC * 1024 * 2;
      {
        g8::Sched2 s = mk_sched(hnc, wb + W_IN, TC, PWP, 1024, 1024);
        s.A1 = (const char*)(wb + W_V); s.B1 = hnc; s.nM1 = 2; s.nN1 = TC / 256;
        g8::EpiProj e{(u16*)(p.ws + O_PROJ), (const float2*)(p.ws + O_ROPE) + (size_t)chunk * TC * 32, (u16*)(p.ws + O_VT)};
        g8::gemm_phase<true>(lds, 1024, 1024, 1024, s, e);
      }
      TICK(3);
      xcd_barrier(xbar); p.ws = launder(p0.ws); p.out = launder(p0.out);
      TICK(11);
      phase_mixers(p, l, ctrs + l * NCHUNK + chunk, smem);
      TICK(4);
      xcd_barrier(xbar); p.ws = launder(p0.ws); p.out = launder(p0.out);
      TICK(11);
      {
        g8::Sched2 s = mk_sched(p.ws + O_YSPRE, wb + W_GLU, TC, 768, 384, 384);
        g8::EpiGlu e{(u16*)(p.ws + O_YCAT), p.in[14] + l * 768};
        g8::gemm_phase<true>(lds, 384, 384, 384, s, e);
      }
      phase_lru2(p);
      TICK(5);
      xcd_barrier(xbar); p.ws = launder(p0.ws); p.out = launder(p0.out);
      TICK(11);
      {
        g8::SchedMerge s;
        s.A = p.ws + O_YCAT; s.B = (const char*)(wb + W_BR); s.nM = TC / 256; s.nN = 4;
        s.tsA = (size_t)256 * YW * 2; s.tsB = (size_t)256 * YW * 2; s.G = gridDim.x; s.c = blockIdx.x;
        g8::EpiGateZ e{(const u16*)(p.ws + O_PROJ), (u16*)(p.ws + O_Z)};
        g8::gemm_phase<true>(lds, 512, YW, YW, s, e);
      }
      TICK(6);
      xcd_barrier(xbar); p.ws = launder(p0.ws); p.out = launder(p0.out);
      TICK(11);
      {
        g8::Sched2 s = mk_sched(p.ws + O_Z, wb + W_OUT, TC, 1024, 3072, 1024);
        g8::EpiResid e{x, l == 0 ? p.in[0] + (size_t)chunk * TC * 1024 : x};
        g8::gemm_phase<false, 16>(lds, 3072, 3072, 1024, s, e);
      }
      TICK(7);
      xcd_barrier(xbar); p.ws = launder(p0.ws); p.out = launder(p0.out);
      TICK(11);
    }
    rmsnorm_rows(p.out, p.in[31] + l * 1024, (u16*)(p.ws + O_HN), T);
    TICK(2);
    xcd_barrier(xbar); p.ws = launder(p0.ws); p.out = launder(p0.out);
    TICK(11);
    {
      g8::Sched2 s = mk_sched(p.ws + O_HN, wb + W_Q, T, 1024, 1024, 1024);
      g8::EpiBf16 e{(u16*)(p.ws + O_QX), 1024, 1024, nullptr, 0, 0};
      g8::gemm_phase<true>(lds, 1024, 1024, 1024, s, e);
    }
    TICK(8);
    xcd_barrier(xbar); p.ws = launder(p0.ws); p.out = launder(p0.out);
    TICK(11);
    phase_xattn(p, smem);
    TICK(9);
    xcd_barrier(xbar); p.ws = launder(p0.ws); p.out = launder(p0.out);
    TICK(11);
    {
      g8::Sched2 s = mk_sched(p.ws + O_OX, wb + W_O, T, 1024, 1024, 1024);
      g8::EpiResid e{p.out, p.out};
      g8::gemm_phase<false>(lds, 1024, 1024, 1024, s, e);
    }
    TICK(7);
    xcd_barrier(xbar); p.ws = launder(p0.ws); p.out = launder(p0.out);
    TICK(11);
    rmsnorm_rows(p.out, p.in[36] + l * 1024, (u16*)(p.ws + O_HN), T);
    TICK(2);
    xcd_barrier(xbar); p.ws = launder(p0.ws); p.out = launder(p0.out);
    TICK(11);
    {
      g8::Sched2 s = mk_sched(p.ws + O_HN, wb + W_UP, TC, DUP, 1024, 1024);
      g8::EpiBf16 e{(u16*)(p.ws + O_UP), DUP, DUP, nullptr, 0, 0};
      g8::gemm_phase<true>(lds, 1024, 1024, 1024, s, e);
    }
    TICK(8);
    xcd_barrier(xbar); p.ws = launder(p0.ws); p.out = launder(p0.out);
    TICK(11);
    for (int chunk = 0; chunk < NCHUNK; chunk++) {
      float* x = p.out + (size_t)chunk * TC * 1024;
      phase_ffn_act(p, l);
      TICK(10);
      xcd_barrier(xbar); p.ws = launder(p0.ws); p.out = launder(p0.out);
      TICK(11);
      {
        g8::Sched2 s = mk_sched(p.ws + O_ACT, wb + W_DOWN, TC, 1024, DFF, DFF);
        g8::EpiResid e{x, x};
        g8::gemm_phase<false>(lds, DFF, DFF, DFF, s, e);
      }
      if (chunk + 1 < NCHUNK) {
        const char* hnc = p.ws + O_HN + (size_t)(chunk + 1) * TC * 1024 * 2;
        g8::Sched2 s = mk_sched(hnc, wb + W_UP, TC, DUP, 1024, 1024);
        g8::EpiBf16 e{(u16*)(p.ws + O_UP), DUP, DUP, nullptr, 0, 0};
        g8::gemm_phase<true>(lds, 1024, 1024, 1024, s, e);
      }
      TICK(7);
      xcd_barrier(xbar); p.ws = launder(p0.ws); p.out = launder(p0.out);
      TICK(11);
    }
  }
#ifdef PROBE_A
  {
    unsigned* mw = (unsigned*)(p0.ws + O_BAR) + 128;
    if (blockIdx.x == 0 && threadIdx.x == 0) {
      __hip_atomic_store(mw, ta / 100u, __ATOMIC_RELAXED, __HIP_MEMORY_SCOPE_AGENT);
      const unsigned t0 = (unsigned)__builtin_amdgcn_s_memrealtime();
      while ((unsigned)__builtin_amdgcn_s_memrealtime() - t0 < tb) __builtin_amdgcn_s_sleep(8);
    }
    xcd_barrier(xbar);
    final_norm(p.out, p.in[41], __hip_atomic_load(mw, __ATOMIC_RELAXED, __HIP_MEMORY_SCOPE_AGENT));
  }
#else
  final_norm(p.out, p.in[41], 0u);
#endif
}

extern "C" void kernel_launch(void* const* d_in, const int* in_sizes, int n_in, void* d_out, int out_size,
                              void* d_ws, size_t ws_size, hipStream_t stream) {
  static int grid_blocks = 0;
  if (!grid_blocks) {
    int dev = 0, cus = 0, per_cu = 0;
    (void)hipGetDevice(&dev);
    (void)hipDeviceGetAttribute(&cus, hipDeviceAttributeMultiprocessorCount, dev);
    if (hipFuncSetAttribute((const void*)mega, hipFuncAttributeMaxDynamicSharedMemorySize, SMEM_BYTES) != hipSuccess)
      fprintf(stderr, "hipFuncSetAttribute failed\n");
    (void)hipOccupancyMaxActiveBlocksPerMultiprocessor(&per_cu, mega, 512, SMEM_BYTES);
    if (per_cu < 1) per_cu = 1;
    grid_blocks = cus;
    if (grid_blocks > NBLK) grid_blocks = NBLK;
  }
  if (ws_size < O_XB + 16384 || n_in < 42) {
    fprintf(stderr, "workspace too small: %zu < %zu\n", ws_size, (size_t)O_END);
    return;
  }
  Params p{};
  for (int i = 0; i < 42; i++) p.in[i] = (const float*)d_in[i];
  p.out = (float*)d_out;
  p.ws = (char*)d_ws;
  (void)hipMemsetAsync(d_ws, 0, 4096, stream);
  (void)hipMemsetAsync((char*)d_ws + O_XB, 0, 16384, stream);
  void* args[] = {&p};
  hipError_t e = hipLaunchCooperativeKernel((void*)mega, dim3(grid_blocks), dim3(512), args, SMEM_BYTES, stream);
  if (e != hipSuccess) fprintf(stderr, "cooperative launch failed: %s (grid %d)\n", hipGetErrorString(e), grid_blocks);
}
```

```cpp
#include <hip/hip_runtime.h>
#include <hip/hip_cooperative_groups.h>
#include <cstdio>
namespace cg = cooperative_groups;

#define DI __device__ __forceinline__
#define LAS __attribute__((address_space(3)))
typedef unsigned short u16;
typedef __attribute__((ext_vector_type(8))) short bf16x8;
typedef __attribute__((ext_vector_type(16))) float f32x16;
typedef __attribute__((ext_vector_type(4))) float f32x4;
typedef __attribute__((ext_vector_type(4))) unsigned u32x4;
typedef __attribute__((ext_vector_type(2))) unsigned u32x2;
typedef __bf16 bf16v2 __attribute__((ext_vector_type(2)));
typedef float f32v2 __attribute__((ext_vector_type(2)));
#define MFMA(a, b, c) __builtin_amdgcn_mfma_f32_32x32x16_bf16((a), (b), (c), 0, 0, 0)

constexpr int D = 1024, BATCH = 16, SEQ = 2048, DEPTH = 4, T = BATCH * SEQ;
constexpr int NB = 8;
constexpr int TC = NB * SEQ;
constexpr int NCHUNK = BATCH / NB;
constexpr int DIN = 6016, DFF = 2816, DUP = 2 * DFF;
constexpr int PW = 5504, PWP = 5632;
constexpr int C_U = 0, C_Q = 384, C_K = 896, C_XR = 1408, C_GR = 1920, C_G = 2432;
constexpr int YW = 1536;
constexpr int MEMR = BATCH * 256;
constexpr float EPS = 1e-6f;
constexpr int NBLK = 256;

constexpr size_t al256(size_t x) { return (x + 255) & ~(size_t)255; }
constexpr size_t W_IN = 0;
constexpr size_t W_V = W_IN + (size_t)PWP * 1024;
constexpr size_t W_GLU = W_V + 512 * 1024;
constexpr size_t W_BR = W_GLU + 768 * 384;
constexpr size_t W_OUT = W_BR + 1024 * YW;
constexpr size_t W_Q = W_OUT + 1024 * 1024;
constexpr size_t W_KV = W_Q + 1024 * 1024;
constexpr size_t W_O = W_KV + 2048 * 1024;
constexpr size_t W_UP = W_O + 1024 * 1024;
constexpr size_t W_DOWN = W_UP + (size_t)DUP * 1024;
constexpr size_t W_END = W_DOWN + (size_t)1024 * DFF;

constexpr size_t O_BAR = 0;
constexpr size_t O_LAM = 1024;
constexpr size_t O_TAB = 2048;
constexpr size_t O_W = 4096;
constexpr size_t O_M2 = al256(O_W + W_END * 2);
constexpr size_t O_M13 = al256(O_M2 + (size_t)96 * 128 * 256 * 2);
constexpr size_t O_A16 = al256(O_M13 + (size_t)96 * 256 * 384 * 2);
constexpr size_t O_ROPE = al256(O_A16 + 96 * 64 * 8);
constexpr size_t O_MEMN = al256(O_ROPE + (size_t)T * 32 * 8);
constexpr size_t O_KX = al256(O_MEMN + (size_t)MEMR * 1024 * 2);
constexpr size_t O_VTX = al256(O_KX + (size_t)MEMR * 1024 * 2);
constexpr size_t O_HN = al256(O_VTX + (size_t)MEMR * 1024 * 2);
constexpr size_t O_PROJ = al256(O_HN + (size_t)T * 1024 * 2);
constexpr size_t O_VT = al256(O_PROJ + (size_t)TC * DUP * 2);
constexpr size_t O_YSPRE = al256(O_VT + (size_t)NB * 512 * 2048 * 2);
constexpr size_t O_YCAT = al256(O_YSPRE + (size_t)TC * 384 * 2);
constexpr size_t O_HLOC = al256(O_YCAT + (size_t)TC * YW * 2);
constexpr size_t O_PACC = al256(O_HLOC + (size_t)TC * 512 * 4);
constexpr size_t O_MERGED = al256(O_PACC + (size_t)TC * 512 * 4);
constexpr size_t O_END = al256(O_MERGED + (size_t)TC * 1024 * 2);
constexpr size_t O_QX = O_PROJ;
constexpr size_t O_OX = O_PROJ + (size_t)T * 1024 * 2;
constexpr size_t O_UP = O_PROJ;
constexpr size_t O_ACT = O_VT;
constexpr size_t O_Z = O_HLOC;
static_assert(O_ACT + (size_t)TC * DFF * 2 <= O_MERGED, "act alias");
static_assert(O_Z + (size_t)TC * 3072 * 2 <= O_END, "z alias");
constexpr size_t O_XB = O_END;
static_assert(O_XB + 16384 <= (size_t)536870912, "workspace");
static_assert((size_t)T * 1024 * 4 <= (size_t)TC * DUP * 2, "qx/ox alias");

constexpr int HALF_LDS = 128 * 528 + 64;
constexpr int SMEM_BYTES = 2 * HALF_LDS;

struct Params {
  const float* in[42];
  float* out;
  char* ws;
};

struct Ctx {
  const float* const* in;
  float* out;
  char* ws;
};

DI float bf2f(u16 v) { return __uint_as_float(((unsigned)v) << 16); }
DI float bflo(unsigned v) { return __uint_as_float(v << 16); }
DI float bfhi(unsigned v) { return __uint_as_float(v & 0xffff0000u); }
DI unsigned pk2(float lo, float hi) {
  f32v2 f = {lo, hi};
  bf16v2 b = __builtin_convertvector(f, bf16v2);
  return __builtin_bit_cast(unsigned, b);
}
DI u16 f2bf(float x) { return (u16)(pk2(x, 0.f) & 0xffffu); }
DI int crow(int i, int hh) { return (i & 3) + 8 * (i >> 2) + 4 * hh; }
DI float sigmoidf_(float x) { return 1.f / (1.f + __expf(-x)); }
DI float gelu_tanh(float x) {
  const float u2 = 1.5957691216057308f * (x + 0.044715f * x * x * x);
  return x / (1.f + __expf(-u2));
}
DI int opaque_bid() { int b = blockIdx.x; asm volatile("" : "+s"(b)); return b; }
DI int opaque_gdim() { int g = gridDim.x; asm volatile("" : "+s"(g)); return g; }
DI int opaque_tid() { int t = threadIdx.x; asm volatile("" : "+v"(t)); return t; }
template <class P> DI P* launder(P* p) { asm volatile("" : "+s"(p)); return p; }
DI int swap23(int t) { return (t & ~12) | ((t & 4) << 1) | ((t & 8) >> 1); }

#define XB_TMO      128
#define XB_XCNT(j)  (256  + 64 * (j))
#define XB_XSUB(j)  (1280 + 64 * (j))
#define XB_XGEN(j)  (2304 + 64 * (j))
#define XB_TOP      3328
#define XB_TOPGEN   3392
#define XB_SPIN_CAP (1u << 18)
DI unsigned xb_ld(unsigned* p)              { return __hip_atomic_load(p, __ATOMIC_RELAXED, __HIP_MEMORY_SCOPE_AGENT); }
DI unsigned xb_add(unsigned* p, unsigned v) { return __hip_atomic_fetch_add(p, v, __ATOMIC_RELAXED, __HIP_MEMORY_SCOPE_AGENT); }
DI unsigned xb_xcc_id() { return (unsigned)__builtin_amdgcn_s_getreg((3 << 11) | 20) & 0xFu; }
#define XB_SPIN(cond, bar) do { unsigned _sp = 0; while (cond) { __builtin_amdgcn_s_sleep(1); \
    if ((++_sp & 255u) == 0u) { if (xb_ld(&(bar)[XB_TMO])) break; if (_sp > XB_SPIN_CAP) { atomicAdd(&(bar)[XB_TMO], 1u); break; } } } } while (0)
struct XcdBarrier { unsigned* bar; unsigned x; volatile unsigned* st; };
DI XcdBarrier xcd_barrier_post(unsigned* bar, volatile unsigned* st) {
  XcdBarrier b; b.bar = bar; b.x = xb_xcc_id(); b.st = st;
  if (threadIdx.x == 0) (void)xb_add(&bar[XB_XCNT(b.x)], 1u);
  return b;
}
DI void xcd_barrier_complete(unsigned* bar, unsigned x, unsigned& nloc, unsigned& nx) {
  const unsigned G = gridDim.x;
  unsigned sum, cnt, mine, sp = 0u;
  for (;;) {
    sum = 0u; cnt = 0u; mine = 0u;
#pragma unroll
    for (unsigned j = 0; j < 16; ++j) { const unsigned c = xb_ld(&bar[XB_XCNT(j)]); sum += c; cnt += (c > 0u) ? 1u : 0u; mine = (j == x) ? c : mine; }
    if (sum == G) break;
    __builtin_amdgcn_s_sleep(1);
    if ((++sp & 255u) == 0u) { if (xb_ld(&bar[XB_TMO])) break; if (sp > XB_SPIN_CAP) { atomicAdd(&bar[XB_TMO], 1u); break; } }
  }
  nloc = mine > 0u ? mine : 1u; nx = cnt > 0u ? cnt : 1u;
}
DI void xcd_barrier(const XcdBarrier& b) {
  asm volatile("s_waitcnt vmcnt(0)" ::: "memory");
  __syncthreads();
  if (threadIdx.x == 0) {
    unsigned* bar = b.bar;
    __builtin_amdgcn_s_waitcnt(0);
    unsigned nloc = b.st[0], nx = b.st[1];
    if (nloc == 0u) { xcd_barrier_complete(bar, b.x, nloc, nx); b.st[0] = nloc; b.st[1] = nx; }
    const unsigned old = xb_add(&bar[XB_XSUB(b.x)], 1u);
    const unsigned gen = old / nloc;
    if (old + 1u == (gen + 1u) * nloc) {
      __builtin_amdgcn_fence(__ATOMIC_RELEASE, "agent");
      asm volatile("s_waitcnt vmcnt(0)" ::: "memory");
      const unsigned og = xb_add(&bar[XB_TOP], 1u);
      const unsigned tg = og / nx;
      if (og + 1u == (tg + 1u) * nx) xb_add(&bar[XB_TOPGEN], 1u);
      else XB_SPIN(xb_ld(&bar[XB_TOPGEN]) == tg, bar);
      __builtin_amdgcn_fence(__ATOMIC_ACQUIRE, "agent");
      xb_add(&bar[XB_XGEN(b.x)], 1u);
      asm volatile("s_waitcnt vmcnt(0)" ::: "memory");
    } else {
      XB_SPIN(xb_ld(&bar[XB_XGEN(b.x)]) == gen, bar);
      __builtin_amdgcn_fence(__ATOMIC_ACQUIRE, "agent");
      asm volatile("s_waitcnt vmcnt(0)" ::: "memory");
    }
  }
  __syncthreads();
}

namespace g8 {
constexpr int BK = 64, HALF = 128, HTB = HALF * BK * 2;
DI int lds_byte(int r, int c) { const int st = (r >> 4) * 2 + (c >> 5), rr = r & 15, cc = c & 31, ob = rr * 64 + cc * 2; return st * 1024 + (ob ^ (((ob >> 9) & 1) << 5)); }
DI void stage_rc(int b, int& R, int& C) { const int st = b / 1024, sb = b % 1024, swz = sb ^ (((sb >> 9) & 1) << 5); R = (st >> 1) * 16 + swz / 64; C = (st & 1) * 32 + (swz % 64) / 2; }
DI int perm32(int rho) { const int n = rho >> 4, i = rho & 15; return 8 * (i >> 2) + 4 * n + (i & 3); }
struct Unit { const char* a; const char* b; int pm, pn, kind; };

DI void remap(int L, int nM, int nN, int& pm, int& pn) {
  const int nwg = nM * nN;
  const int q = nwg / 8, r = nwg % 8, xcd = L % 8, off = L / 8;
  const int wgid = (xcd < r ? xcd * (q + 1) : r * (q + 1) + (xcd - r) * q) + off;
  const int nig = 8 * nN, gid = wgid / nig, fm = gid * 8, gsz = (nM - fm) < 8 ? (nM - fm) : 8;
  pm = fm + ((wgid % nig) % gsz);
  pn = (wgid % nig) / gsz;
}
struct Sched2 {
  const char *A0, *B0, *A1, *B1;
  int nM0, nN0, nM1, nN1;
  size_t tsA, tsB;
  int G, c;
  DI bool next(int i, Unit& u) const {
    const int L = i * G + c, n0 = nM0 * nN0;
    if (L < n0) { remap(L, nM0, nN0, u.pm, u.pn); u.a = A0 + (size_t)u.pm * tsA; u.b = B0 + (size_t)u.pn * tsB; u.kind = 0; return true; }
    if (L < n0 + nM1 * nN1) { remap(L - n0, nM1, nN1, u.pm, u.pn); u.a = A1 + (size_t)u.pm * tsA; u.b = B1 + (size_t)u.pn * tsB; u.kind = 1; return true; }
    return false;
  }
};
struct SchedMerge {
  const char *A, *B;
  int nM, nN;
  size_t tsA, tsB;
  int G, c;
  DI bool next(int i, Unit& u) const {
    const int L = i * G + c, nt = nM * nN;
    if (L >= 3 * nt) return false;
    const int br = L / nt;
    remap(L - br * nt, nM, nN, u.pm, u.pn);
    u.a = A + (size_t)u.pm * tsA + br * 1024; u.b = B + (size_t)u.pn * tsB + br * 1024; u.kind = br;
    return true;
  }
};

template <bool PERM, int BWRAP = 0, class Sched, class Epi>
DI void gemm_phase(LAS unsigned char* lds, const int K, const int lda, const int ldb, const Sched& S, const Epi& E) {
  const int tid = opaque_tid(), wid = __builtin_amdgcn_readfirstlane(tid >> 6), lane = tid & 63, wr = wid >> 2, wc = wid & 3, fr = lane & 15, fq = lane >> 4;
  const int nt = K / BK;
  unsigned voffA[2], voffB[2];
#pragma unroll
  for (int i = 0; i < 2; ++i) {
    int R, C; stage_rc(tid * 16 + i * 8192, R, C);
    const int Rb = PERM ? ((R & ~31) + perm32(R & 31)) : R;
    voffA[i] = (unsigned)(R * lda + C) * 2u; voffB[i] = (unsigned)(Rb * ldb + C) * 2u;
  }
  const size_t kstep = (size_t)(BK * 2);
  const size_t hstepA = (size_t)HALF * lda * 2, hstepB = (size_t)HALF * ldb * 2;
  const unsigned ldsw = (unsigned)wid * 1024u;
  const int aoff = lds_byte(wr * 64 + fr, fq * 8), boff = lds_byte(wc * 32 + fr, fq * 8);
#define G8_SA(b, h) (((b) * 2 + (h)) * HTB)
#define G8_SB(b, h) ((4 + (b) * 2 + (h)) * HTB)
#define G8_STAGE(bufoff, gbase, voff) do { _Pragma("unroll") for (int _i = 0; _i < 2; ++_i) \
    __builtin_amdgcn_global_load_lds((const unsigned*)((const char*)(gbase) + (voff)[_i]), (LAS unsigned*)(lds + (bufoff) + ldsw + _i * 8192), 16, 0, 0); } while (0)
#define G8_LDA(dst, b, h) do { _Pragma("unroll") for (int m = 0; m < 4; ++m) _Pragma("unroll") for (int k = 0; k < 2; ++k) dst[m][k] = *(const LAS bf16x8*)(lds + G8_SA(b, h) + aoff + m * 2048 + k * 1024); } while (0)
#define G8_LDB(dst, b, h) do { _Pragma("unroll") for (int n = 0; n < 2; ++n) _Pragma("unroll") for (int k = 0; k < 2; ++k) dst[n][k] = *(const LAS bf16x8*)(lds + G8_SB(b, h) + boff + n * 2048 + k * 1024); } while (0)
#define G8_MMA(ai, bj, At, Bt) do { __builtin_amdgcn_s_setprio(1); _Pragma("unroll") for (int m = 0; m < 4; ++m) _Pragma("unroll") for (int n = 0; n < 2; ++n) _Pragma("unroll") for (int k = 0; k < 2; ++k) \
    acc[ai][bj][m][n] = __builtin_amdgcn_mfma_f32_16x16x32_bf16(Bt[n][k], At[m][k], acc[ai][bj][m][n], 0, 0, 0); __builtin_amdgcn_s_setprio(0); } while (0)
#define G8_WAIT_V(n) asm volatile("s_waitcnt vmcnt(" #n ")" ::: "memory")
#define G8_WAIT_L(n) asm volatile("s_waitcnt lgkmcnt(" #n ")" ::: "memory")
#define G8_BAR __builtin_amdgcn_s_barrier()
#define G8_SCHED __builtin_amdgcn_sched_barrier(0)
  Unit cur, nxt; int ui = 0;
  if (!S.next(0, cur)) return;
  f32x4 acc[2][2][4][2];
  E.init(acc, cur, wr, wc, fr, fq);
  bf16x8 At[4][2], B0[2][2], B1[2][2];
  const char* cA = cur.a; const char* cB = cur.b;
  G8_STAGE(G8_SB(0, 0), cB, voffB); G8_STAGE(G8_SA(0, 0), cA, voffA); G8_STAGE(G8_SB(0, 1), cB + hstepB, voffB); G8_STAGE(G8_SA(0, 1), cA + hstepA, voffA);
  if (wr == 1) G8_BAR;
  G8_WAIT_V(4); G8_BAR;
  G8_STAGE(G8_SB(1, 0), cB + kstep, voffB); G8_STAGE(G8_SA(1, 0), cA + kstep, voffA); G8_STAGE(G8_SB(1, 1), cB + hstepB + kstep, voffB);
  G8_WAIT_V(6); G8_BAR;
  for (;;) {
    const bool has_next = S.next(ui + 1, nxt);
    const char* nA = has_next ? nxt.a : cA; const char* nB = has_next ? nxt.b : cB;
#pragma unroll 1
    for (int t = 0; t < nt; t += 2) {
      const bool last = (t == nt - 2);
      const char* a1 = cA + (size_t)(t + 1) * kstep;
      const char* a2 = last ? nA : cA + (size_t)(t + 2) * kstep;
      const char* b2 = last ? nB : cB + (size_t)(BWRAP ? ((t + 2) & (BWRAP - 1)) : (t + 2)) * kstep;
      const char* a3 = a2 + kstep; const char* b3 = b2 + kstep;
      G8_LDB(B0, 0, 0); G8_SCHED; G8_LDA(At, 0, 0); G8_STAGE(G8_SA(1, 1), a1 + hstepA, voffA);
      G8_WAIT_L(8); G8_BAR; G8_WAIT_L(0); G8_MMA(0, 0, At, B0); G8_BAR; G8_SCHED;
      G8_LDB(B1, 0, 1); G8_STAGE(G8_SB(0, 0), b2, voffB);
      G8_BAR; G8_WAIT_L(0); G8_MMA(0, 1, At, B1); G8_BAR;
      G8_LDA(At, 0, 1); G8_STAGE(G8_SA(0, 0), a2, voffA);
      G8_BAR; G8_WAIT_L(0); G8_MMA(1, 0, At, B0); G8_BAR; G8_SCHED;
      G8_STAGE(G8_SB(0, 1), b2 + hstepB, voffB);
      G8_WAIT_V(6); G8_BAR; G8_MMA(1, 1, At, B1); G8_BAR;
      G8_LDB(B0, 1, 0); G8_SCHED; G8_LDA(At, 1, 0); G8_STAGE(G8_SA(0, 1), a2 + hstepA, voffA);
      G8_WAIT_L(8); G8_BAR; G8_WAIT_L(0); G8_MMA(0, 0, At, B0); G8_BAR; G8_SCHED;
      G8_LDB(B1, 1, 1); G8_STAGE(G8_SB(1, 0), b3, voffB);
      G8_BAR; G8_WAIT_L(0); G8_MMA(0, 1, At, B1); G8_BAR;
      G8_LDA(At, 1, 1); G8_STAGE(G8_SA(1, 0), a3, voffA);
      G8_BAR; G8_WAIT_L(0); G8_MMA(1, 0, At, B0); G8_BAR; G8_SCHED;
      G8_STAGE(G8_SB(1, 1), b3 + hstepB, voffB);
      G8_WAIT_V(6); G8_BAR; G8_MMA(1, 1, At, B1); G8_BAR;
    }
    E(acc, cur, wr, wc, fr, fq);
    if (!has_next) break;
    E.init(acc, nxt, wr, wc, fr, fq);
    cur = nxt; cA = nA; cB = nB; ++ui;
  }
  G8_WAIT_V(0);
  if (wr == 0) G8_BAR;
  G8_BAR;
#undef G8_SA
#undef G8_SB
#undef G8_STAGE
#undef G8_LDA
#undef G8_LDB
#undef G8_MMA
#undef G8_WAIT_V
#undef G8_WAIT_L
#undef G8_BAR
#undef G8_SCHED
}

typedef const f32x4 (&AccRef)[2][2][4][2];
typedef f32x4 (&AccMut)[2][2][4][2];
DI void zero_acc(AccMut acc) {
#pragma unroll
  for (int a = 0; a < 2; ++a)
#pragma unroll
    for (int b = 0; b < 2; ++b)
#pragma unroll
      for (int m = 0; m < 4; ++m)
#pragma unroll
        for (int n = 0; n < 2; ++n) acc[a][b][m][n] = (f32x4){0.f, 0.f, 0.f, 0.f};
}
#define ZERO_INIT DI void init(AccMut acc, const Unit&, int, int, int, int) const { zero_acc(acc); }

struct EpiBf16 {
  u16* C; int ldc; int ncols;
  u16* Tt; int tseq_log2; int tch;
  ZERO_INIT
  DI void operator()(AccRef acc, const Unit& u, int wr, int wc, int fr, int fq) const {
    const int row0 = u.pm * 256 + wr * 64 + fr, col0 = u.pn * 256 + wc * 32 + 8 * fq;
    if (u.kind == 0) {
#pragma unroll
      for (int ai = 0; ai < 2; ++ai)
#pragma unroll
        for (int m = 0; m < 4; ++m) {
          u16* rowp = C + (size_t)(row0 + ai * 128 + m * 16) * ldc + col0;
#pragma unroll
          for (int bj = 0; bj < 2; ++bj) {
            if (col0 + bj * 128 < ncols) {
              const f32x4 v0 = acc[ai][bj][m][0], v1 = acc[ai][bj][m][1];
              u32x4 w = {pk2(v0[0], v0[1]), pk2(v0[2], v0[3]), pk2(v1[0], v1[1]), pk2(v1[2], v1[3])};
              *(u32x4*)(rowp + bj * 128) = w;
            }
          }
        }
    } else {
      const int smask = (1 << tseq_log2) - 1;
#pragma unroll
      for (int ai = 0; ai < 2; ++ai)
#pragma unroll
        for (int m = 0; m < 4; ++m) {
          const int ch = row0 + ai * 128 + m * 16;
#pragma unroll
          for (int bj = 0; bj < 2; ++bj) {
            const int tg = col0 + bj * 128;
            const int sq = tg >> tseq_log2, t = tg & smask;
            u16* base = Tt + ((size_t)(sq * tch + ch) << tseq_log2);
            const f32x4 v0 = acc[ai][bj][m][0], v1 = acc[ai][bj][m][1];
            u32x2 w0 = {pk2(v0[0], v0[1]), pk2(v0[2], v0[3])}, w1 = {pk2(v1[0], v1[1]), pk2(v1[2], v1[3])};
            *(u32x2*)(base + swap23(t)) = w0;
            *(u32x2*)(base + swap23(t + 4)) = w1;
          }
        }
    }
  }
};

struct EpiProj {
  u16* proj; const float2* rope; u16* vt;
  ZERO_INIT
  DI void operator()(AccRef acc, const Unit& u, int wr, int wc, int fr, int fq) const {
    const int row0 = u.pm * 256 + wr * 64 + fr, col0 = u.pn * 256 + wc * 32 + 8 * fq;
    if (u.kind == 0) {
#pragma unroll
      for (int bj = 0; bj < 2; ++bj) {
        const int cb = col0 + bj * 128;
        if (cb >= PW) continue;
        const bool isrope = (cb >= C_Q) && (cb < C_XR);
        if (isrope) {
          const int p0 = cb & 63, d0 = p0 >> 1, blk = cb - p0;
#pragma unroll
          for (int ai = 0; ai < 2; ++ai) {
            float4 cs[4][2];
#pragma unroll
            for (int m = 0; m < 4; ++m) {
              const int row = row0 + ai * 128 + m * 16;
              cs[m][0] = *(const float4*)(rope + (size_t)row * 32 + d0);
              cs[m][1] = *(const float4*)(rope + (size_t)row * 32 + d0 + 2);
            }
            asm volatile("" ::: "memory");
#pragma unroll
            for (int m = 0; m < 4; ++m) {
              const int row = row0 + ai * 128 + m * 16;
              const f32x4 x1 = acc[ai][bj][m][0], x2 = acc[ai][bj][m][1];
              const float c0 = cs[m][0].x, s0 = cs[m][0].y, c1 = cs[m][0].z, s1 = cs[m][0].w, c2 = cs[m][1].x, s2 = cs[m][1].y, c3 = cs[m][1].z, s3 = cs[m][1].w;
              u32x2 lo = {pk2(x1[0] * c0 - x2[0] * s0, x1[1] * c1 - x2[1] * s1), pk2(x1[2] * c2 - x2[2] * s2, x1[3] * c3 - x2[3] * s3)};
              u32x2 hi = {pk2(x2[0] * c0 + x1[0] * s0, x2[1] * c1 + x1[1] * s1), pk2(x2[2] * c2 + x1[2] * s2, x2[3] * c3 + x1[3] * s3)};
              u16* rp = proj + (size_t)row * PW + blk + d0;
              *(u32x2*)rp = lo;
              *(u32x2*)(rp + 32) = hi;
            }
          }
        } else {
#pragma unroll
          for (int ai = 0; ai < 2; ++ai)
#pragma unroll
            for (int m = 0; m < 4; ++m) {
              const int row = row0 + ai * 128 + m * 16;
              const f32x4 v0 = acc[ai][bj][m][0], v1 = acc[ai][bj][m][1];
              u32x4 w = {pk2(v0[0], v0[1]), pk2(v0[2], v0[3]), pk2(v1[0], v1[1]), pk2(v1[2], v1[3])};
              *(u32x4*)(proj + (size_t)row * PW + cb) = w;
            }
        }
      }
    } else {
#pragma unroll
      for (int ai = 0; ai < 2; ++ai)
#pragma unroll
        for (int m = 0; m < 4; ++m) {
          const int ch = row0 + ai * 128 + m * 16;
#pragma unroll
          for (int bj = 0; bj < 2; ++bj) {
            const int tg = col0 + bj * 128;
            const int sq = tg >> 11, t = tg & 2047;
            u16* base = vt + ((size_t)(sq * 512 + ch) << 11);
            const f32x4 v0 = acc[ai][bj][m][0], v1 = acc[ai][bj][m][1];
            u32x2 w0 = {pk2(v0[0], v0[1]), pk2(v0[2], v0[3])}, w1 = {pk2(v1[0], v1[1]), pk2(v1[2], v1[3])};
            *(u32x2*)(base + swap23(t)) = w0;
            *(u32x2*)(base + swap23(t + 4)) = w1;
          }
        }
    }
  }
};

struct EpiResid {
  float* X; const float* Xin;
  DI void init(AccMut acc, const Unit& u, int wr, int wc, int fr, int fq) const {
    const int row0 = u.pm * 256 + wr * 64 + fr, col0 = u.pn * 256 + wc * 32 + 4 * fq;
#pragma unroll
    for (int ai = 0; ai < 2; ++ai)
#pragma unroll
      for (int m = 0; m < 4; ++m) {
        const float* rowp = Xin + (size_t)(row0 + ai * 128 + m * 16) * 1024 + col0;
#pragma unroll
        for (int bj = 0; bj < 2; ++bj)
#pragma unroll
          for (int n = 0; n < 2; ++n) acc[ai][bj][m][n] = *(const f32x4*)(rowp + bj * 128 + n * 16);
      }
  }
  DI void operator()(AccRef acc, const Unit& u, int wr, int wc, int fr, int fq) const {
    const int row0 = u.pm * 256 + wr * 64 + fr, col0 = u.pn * 256 + wc * 32 + 4 * fq;
#pragma unroll
    for (int ai = 0; ai < 2; ++ai)
#pragma unroll
      for (int m = 0; m < 4; ++m) {
        float* rowp = X + (size_t)(row0 + ai * 128 + m * 16) * 1024 + col0;
#pragma unroll
        for (int bj = 0; bj < 2; ++bj)
#pragma unroll
          for (int n = 0; n < 2; ++n) *(f32x4*)(rowp + bj * 128 + n * 16) = acc[ai][bj][m][n];
      }
  }
};

struct EpiGlu {
  u16* ycat; const float* bias;
  ZERO_INIT
  DI void operator()(AccRef acc, const Unit& u, int wr, int wc, int fr, int fq) const {
    const int row0 = u.pm * 256 + wr * 64 + fr, col0 = u.pn * 256 + wc * 32 + 8 * fq;
#pragma unroll
    for (int bj = 0; bj < 2; ++bj) {
      const int c = (col0 + bj * 128) >> 1;
      const float4 b1 = *(const float4*)(bias + c), b2 = *(const float4*)(bias + 384 + c);
#pragma unroll
      for (int ai = 0; ai < 2; ++ai)
#pragma unroll
        for (int m = 0; m < 4; ++m) {
          const int row = row0 + ai * 128 + m * 16;
          const f32x4 v = acc[ai][bj][m][0], g = acc[ai][bj][m][1];
          u32x2 w = {pk2((v[0] + b1.x) * sigmoidf_(g[0] + b2.x), (v[1] + b1.y) * sigmoidf_(g[1] + b2.y)),
                     pk2((v[2] + b1.z) * sigmoidf_(g[2] + b2.z), (v[3] + b1.w) * sigmoidf_(g[3] + b2.w))};
          *(u32x2*)(ycat + (size_t)row * YW + c) = w;
          asm volatile("" ::: "memory");
        }
    }
  }
};

struct EpiGateZ {
  const u16* proj; u16* z;
  ZERO_INIT
  DI void operator()(AccRef acc, const Unit& u, int wr, int wc, int fr, int fq) const {
    const int row0 = u.pm * 256 + wr * 64 + fr, col0 = u.pn * 256 + wc * 32 + 8 * fq;
    const int br = u.kind;
    u32x4 gw[2][4][2];
#pragma unroll
    for (int ai = 0; ai < 2; ++ai)
#pragma unroll
      for (int m = 0; m < 4; ++m)
#pragma unroll
        for (int bj = 0; bj < 2; ++bj)
          gw[ai][m][bj] = *(const u32x4*)(proj + (size_t)(row0 + ai * 128 + m * 16) * PW + C_G + br * 1024 + col0 + bj * 128);
    asm volatile("" ::: "memory");
#pragma unroll
    for (int ai = 0; ai < 2; ++ai)
#pragma unroll
      for (int m = 0; m < 4; ++m) {
        const int row = row0 + ai * 128 + m * 16;
#pragma unroll
        for (int bj = 0; bj < 2; ++bj) {
          const int col = col0 + bj * 128;
          const u32x4 g4 = gw[ai][m][bj];
          const f32x4 a0 = acc[ai][bj][m][0], a1 = acc[ai][bj][m][1];
          u32x4 w = {pk2(sigmoidf_(bflo(g4[0])) * a0[0], sigmoidf_(bfhi(g4[0])) * a0[1]), pk2(sigmoidf_(bflo(g4[1])) * a0[2], sigmoidf_(bfhi(g4[1])) * a0[3]),
                     pk2(sigmoidf_(bflo(g4[2])) * a1[0], sigmoidf_(bfhi(g4[2])) * a1[1]), pk2(sigmoidf_(bflo(g4[3])) * a1[2], sigmoidf_(bfhi(g4[3])) * a1[3])};
          *(u32x4*)(z + (size_t)row * 3072 + br * 1024 + col) = w;
        }
      }
  }
};
}

template <class PT> DI void phase_convert_weights(const PT& p, int l, char* smem) {
  u16* wb = (u16*)(p.ws + O_W);
  const int tid = opaque_tid(), half = tid >> 8, ht = tid & 255;
  float* tile = (float*)(smem + half * HALF_LDS);
  const int vb = opaque_bid() * 2 + half, vg = opaque_gdim() * 2;
  constexpr int NT = 5320;
  for (int t = vb; t < NT; t += vg) {
    const float* src; int K, N, base, ldd; size_t dst; int perm = 0, kofs = 0;
    if (t < 1504)      { src = p.in[4] + (size_t)l * 1024 * DIN;  K = 1024; N = DIN;  dst = W_IN;  base = 0; perm = 2; }
    else if (t < 1576) { src = p.in[13] + (size_t)l * 384 * 768;  K = 384;  N = 768;  dst = W_GLU; base = 1504; perm = 1; }
    else if (t < 1672) { src = p.in[27] + (size_t)l * 384 * 1024; K = 384;  N = 1024; dst = W_BR; base = 1576; perm = 3; kofs = 0; }
    else if (t < 1800) { src = p.in[28] + (size_t)l * 512 * 1024; K = 512;  N = 1024; dst = W_BR; base = 1672; perm = 3; kofs = 512; }
    else if (t < 1928) { src = p.in[29] + (size_t)l * 512 * 1024; K = 512;  N = 1024; dst = W_BR; base = 1800; perm = 3; kofs = 1024; }
    else if (t < 2184) { src = p.in[30] + (size_t)l * 1024 * 1024; K = 1024; N = 1024; dst = W_OUT; base = 1928; }
    else if (t < 2440) { src = p.in[33] + (size_t)l * 1024 * 1024; K = 1024; N = 1024; dst = W_Q;   base = 2184; }
    else if (t < 2952) { src = p.in[34] + (size_t)l * 1024 * 2048; K = 1024; N = 2048; dst = W_KV;  base = 2440; }
    else if (t < 3208) { src = p.in[35] + (size_t)l * 1024 * 1024; K = 1024; N = 1024; dst = W_O;   base = 2952; }
    else if (t < 4616) { src = p.in[37] + (size_t)l * 1024 * DUP;  K = 1024; N = DUP;  dst = W_UP;  base = 3208; }
    else               { src = p.in[40] + (size_t)l * DFF * 1024;  K = DFF;  N = 1024; dst = W_DOWN; base = 4616; }
    ldd = (perm == 3) ? YW : K;
    const int lt = t - base;
    const int ntn = N >> 6;
    const int k0 = (lt / ntn) << 6, n0 = (lt % ntn) << 6;
    __syncthreads();
#pragma unroll
    for (int i = 0; i < 4; i++) {
      const int idx = ht + 256 * i, kk = idx >> 4, c4 = idx & 15;
      const float4 v = *(const float4*)(src + (size_t)(k0 + kk) * N + n0 + c4 * 4);
      float* tp = tile + kk * 65 + c4 * 4;
      tp[0] = v.x; tp[1] = v.y; tp[2] = v.z; tp[3] = v.w;
    }
    __syncthreads();
    const int nn = ht >> 2, kq = ht & 3;
    const int c = n0 + nn;
    size_t drow = c;
    if (perm == 1) {
      drow = (c < 384) ? (8 * (c >> 2) + (c & 3)) : (8 * ((c - 384) >> 2) + 4 + ((c - 384) & 3));
    } else if (perm == 2) {
      if (c < C_Q) drow = c;
      else if (c < 1408) {
        const int blk = (c - 384) >> 6, d = (c - 384) & 63;
        const int pp = (d < 32) ? (8 * (d >> 2) + (d & 3)) : (8 * ((d - 32) >> 2) + 4 + ((d - 32) & 3));
        drow = 384 + blk * 64 + pp;
      } else if (c < 1920) drow = (size_t)PWP + (c - 1408);
      else drow = c - 512;
    }
    unsigned pk[8];
#pragma unroll
    for (int j = 0; j < 8; j++)
      pk[j] = pk2(tile[(kq * 16 + 2 * j) * 65 + nn], tile[(kq * 16 + 2 * j + 1) * 65 + nn]);
    u32x4* dp = (u32x4*)(wb + dst + drow * ldd + kofs + k0 + kq * 16);
    u32x4 v0 = {pk[0], pk[1], pk[2], pk[3]}, v1 = {pk[4], pk[5], pk[6], pk[7]};
    dp[0] = v0; dp[1] = v1;
  }
  {
    const int gt = blockIdx.x * 512 + tid, gs = gridDim.x * 512;
    for (int e = gt; e < 1024 * 16; e += gs) {
      const int r = e >> 4, cc = e & 15;
      unsigned zz = 0u; asm volatile("" : "+v"(zz)); u32x4 z = {zz, zz, zz, zz};
      *(u32x4*)(wb + W_BR + (size_t)r * YW + 384 + cc * 8) = z;
    }
  }
}

template <class PT> DI void phase_ssm_setup(const PT& p, char* smem) {
  const int tid = opaque_tid();
  char* hs = smem;
  double2* E = (double2*)hs;
  double2* Bb = (double2*)(hs + 17408);
  float2* Cc = (float2*)(hs + 17408 + 16384);
  float* Kt = (float*)(hs + 17408 + 16384 + 8192);
  for (int lg = blockIdx.x; lg < 96; lg += gridDim.x) {
    const int l = lg / 24, g = lg - l * 24;
    __syncthreads();
    if (tid < 64) {
      const int pp = tid;
      const double lr = p.in[5][(l * 24 + g) * 64 + pp], li = p.in[6][(l * 24 + g) * 64 + pp];
      const double dt = exp((double)p.in[7][l * 24 + g]);
      const double mag = exp(lr * dt);
      const double ar = mag * cos(li * dt), ai = mag * sin(li * dt);
      const double den = lr * lr + li * li, nr = ar - 1.0;
      const double fr = (nr * lr + ai * li) / den, fi = (ai * lr - nr * li) / den;
      double er = 1.0, ei = 0.0;
      for (int k = 0; k <= 16; k++) {
        E[pp * 17 + k] = make_double2(er, ei);
        const double tr = er * ar - ei * ai, ti = er * ai + ei * ar;
        er = tr; ei = ti;
      }
      for (int h = 0; h < 16; h++) {
        const double br = p.in[8][((size_t)(l * 24 + g) * 64 + pp) * 16 + h];
        const double bi = p.in[9][((size_t)(l * 24 + g) * 64 + pp) * 16 + h];
        Bb[pp * 16 + h] = make_double2(fr * br - fi * bi, fr * bi + fi * br);
      }
      ((float2*)(p.ws + O_A16))[lg * 64 + pp] = make_float2((float)E[pp * 17 + 16].x, (float)E[pp * 17 + 16].y);
    }
    for (int e = tid; e < 1024; e += 512) {
      Cc[e] = make_float2(p.in[10][(size_t)(l * 24 + g) * 1024 + e], p.in[11][(size_t)(l * 24 + g) * 1024 + e]);
    }
    __syncthreads();
    for (int e = tid; e < 4096; e += 512) {
      const int tau = e >> 8, h = (e >> 4) & 15, h2 = e & 15;
      double s = 0.0;
      for (int pp = 0; pp < 64; pp++) {
        const double2 a = E[pp * 17 + tau];
        const double2 b = Bb[pp * 16 + h2];
        const float2 c = Cc[h * 64 + pp];
        const double zr = a.x * b.x - a.y * b.y, zi = a.x * b.y + a.y * b.x;
        s += (double)c.x * zr - (double)c.y * zi;
      }
      Kt[e] = (float)s;
    }
    __syncthreads();
    u16* m2 = (u16*)(p.ws + O_M2) + (size_t)lg * 128 * 256;
    for (int e = tid; e < 128 * 256; e += 512) {
      const int n = e >> 8, kk = e & 255;
      const int j = kk >> 4, h2 = kk & 15, pp = n & 63;
      const double2 a = E[pp * 17 + 15 - j];
      const double2 b = Bb[pp * 16 + h2];
      const double zr = a.x * b.x - a.y * b.y, zi = a.x * b.y + a.y * b.x;
      m2[e] = f2bf((float)(n < 64 ? zr : zi));
    }
    u16* m13 = (u16*)(p.ws + O_M13) + (size_t)lg * 256 * 384;
    for (int e = tid; e < 256 * 384; e += 512) {
      const int n = e / 384, kk = e - n * 384;
      const int i = n >> 4, h = n & 15;
      float v;
      if (kk < 256) {
        const int j = kk >> 4, h2 = kk & 15;
        v = (j <= i) ? Kt[((i - j) << 8) + (h << 4) + h2] : 0.f;
      } else {
        const int q = kk - 256, pp = q & 63;
        const double2 a = E[pp * 17 + i + 1];
        const float2 c = Cc[h * 64 + pp];
        const double zr = (double)c.x * a.x - (double)c.y * a.y, zi = (double)c.x * a.y + (double)c.y * a.x;
        v = (float)(q < 64 ? zr : -zi);
      }
      m13[e] = f2bf(v);
    }
  }
}

template <class PT> DI void phase_init(const PT& p) {
  const size_t gtid = (size_t)blockIdx.x * 512 + opaque_tid(), gsz = (size_t)gridDim.x * 512;
  float2* rope = (float2*)(p.ws + O_ROPE);
  const int* pos = (const int*)p.in[2];
  for (size_t e = gtid; e < (size_t)T * 32; e += gsz) {
    const int t = (int)(e >> 5), d = (int)(e & 31);
    const float inv = (float)exp(-9.210340371976184 * (double)(2 * d) / 64.0);
    const float ang = (float)pos[t] * inv;
    rope[e] = make_float2((float)cos((double)ang), (float)sin((double)ang));
  }
  if (blockIdx.x == gridDim.x - 1 && threadIdx.x < 64 * DEPTH) {
    const int ll = threadIdx.x >> 6, i = threadIdx.x & 63;
    float d1 = p.in[15][ll * 64 + i] * p.in[16][ll * 64 + i], d2 = p.in[17][ll * 64 + i] * p.in[18][ll * 64 + i];
#pragma unroll
    for (int o = 32; o > 0; o >>= 1) { d1 += __shfl_xor(d1, o); d2 += __shfl_xor(d2, o); }
    const float lam_init = 0.8f - 0.6f * expf(-0.3f * (float)ll);
    if (i == 0) ((float2*)(p.ws + O_LAM))[ll] = make_float2(expf(d1) - expf(d2) + lam_init, lam_init);
  }
}

DI void rmsnorm_rows(const float* __restrict__ x, const float* __restrict__ g, u16* __restrict__ out, int nrows) {
  const int tid = opaque_tid();
  const int lane = tid & 63;
  const int gw = blockIdx.x * 8 + (tid >> 6), nw = gridDim.x * 8;
  for (int r = gw; r < nrows; r += nw) {
    const float4* xr = (const float4*)(x + (size_t)r * 1024);
    float4 v[4];
    float ss = 0.f;
#pragma unroll
    for (int i = 0; i < 4; i++) {
      v[i] = xr[lane + 64 * i];
      ss += v[i].x * v[i].x + v[i].y * v[i].y + v[i].z * v[i].z + v[i].w * v[i].w;
    }
#pragma unroll
    for (int o = 32; o > 0; o >>= 1) ss += __shfl_xor(ss, o);
    const float rs = rsqrtf(ss * (1.f / 1024.f) + EPS);
#pragma unroll
    for (int i = 0; i < 4; i++) {
      const float4 gg = ((const float4*)g)[lane + 64 * i];
      u32x2 o2 = {pk2(v[i].x * rs * gg.x, v[i].y * rs * gg.y), pk2(v[i].z * rs * gg.z, v[i].w * rs * gg.w)};
      *(u32x2*)(out + (size_t)r * 1024 + (lane + 64 * i) * 4) = o2;
    }
  }
}

DI void final_norm(float* x, const float* __restrict__ g, unsigned mpert) {
  const int tid = opaque_tid();
  const int lane = tid & 63;
  const int gw = blockIdx.x * 8 + (tid >> 6), nw = gridDim.x * 8;
  for (int r = gw; r < T; r += nw) {
    float4* xr = (float4*)(x + (size_t)r * 1024);
    float4 v[4];
    float ss = 0.f;
#pragma unroll
    for (int i = 0; i < 4; i++) {
      v[i] = xr[lane + 64 * i];
      ss += v[i].x * v[i].x + v[i].y * v[i].y + v[i].z * v[i].z + v[i].w * v[i].w;
    }
#pragma unroll
    for (int o = 32; o > 0; o >>= 1) ss += __shfl_xor(ss, o);
    const float rs = rsqrtf(ss * (1.f / 1024.f) + EPS);
#pragma unroll
    for (int i = 0; i < 4; i++) {
      const float4 gg = ((const float4*)g)[lane + 64 * i];
      const unsigned e0 = (unsigned)r * 1024u + (unsigned)(lane + 64 * i) * 4u;
      const float pd = 0.05f;
      xr[lane + 64 * i] = make_float4(v[i].x * rs * gg.x + (e0 < mpert ? pd : 0.f), v[i].y * rs * gg.y + (e0 + 1 < mpert ? pd : 0.f),
                                      v[i].z * rs * gg.z + (e0 + 2 < mpert ? pd : 0.f), v[i].w * rs * gg.w + (e0 + 3 < mpert ? pd : 0.f));
    }
  }
}

template <class PT> DI void attn_item(const PT& p, int l, int bl, int h, int qb, char* smem) {
  const u16* proj = (const u16*)(p.ws + O_PROJ);
  const u16* vt = (const u16*)(p.ws + O_VT);
  u16* ycat = (u16*)(p.ws + O_YCAT);
  const int tid = opaque_tid(), comp = tid >> 8, ht = tid & 255, lane = tid & 63, wave = ht >> 6;
  const int l32 = lane & 31, hh = lane >> 5;
  const int qrow0 = qb * 128 + wave * 32;
  const size_t rowbase = (size_t)bl * 2048;
  char* sK = smem + comp * 9216;
  char* sV = smem + 18432;
  float* sX = (float*)(smem + 40960);
  const float sc = 0.125f * 1.4426950408889634f;
  const float2 lamv = ((const float2*)(p.ws + O_LAM))[l];
  const float lam = lamv.x, lam_init = lamv.y;

  bf16x8 Qf[4];
  {
    const u16* qp = proj + (rowbase + qrow0 + l32) * PW + C_Q + h * 128 + comp * 64 + hh * 8;
#pragma unroll
    for (int s = 0; s < 4; s++) Qf[s] = *(const bf16x8*)(qp + s * 16);
  }
  f32x16 O[4];
#pragma unroll
  for (int a = 0; a < 4; a++)
#pragma unroll
    for (int i = 0; i < 16; i++) O[a][i] = 0.f;
  float m_run = -1e30f, l_run = 0.f;
  const int nkt = 2 * (qb + 1);
  const u16* kp = proj + (rowbase + (ht >> 3)) * PW + C_K + h * 128 + comp * 64 + (ht & 7) * 8;
  const u16* vp = vt + ((size_t)(bl * 512 + h * 128 + (tid >> 3))) * 2048 + (tid & 7) * 8;
  u32x4 rk[2], rv[2];
#pragma unroll
  for (int i = 0; i < 2; i++) rk[i] = *(const u32x4*)(kp + (size_t)(32 * i) * PW);
#pragma unroll
  for (int i = 0; i < 2; i++) rv[i] = *(const u32x4*)(vp + (size_t)(64 * i) * 2048);
  const int wofsK = (ht >> 3) * 144 + (ht & 7) * 16;
  const int wofsV = (tid >> 3) * 144 + (tid & 7) * 16;
  for (int kt = 0; kt < nkt; kt++) {
    __syncthreads();
#pragma unroll
    for (int i = 0; i < 2; i++) *(u32x4*)(sK + wofsK + i * 32 * 144) = rk[i];
#pragma unroll
    for (int i = 0; i < 2; i++) *(u32x4*)(sV + wofsV + i * 64 * 144) = rv[i];
    __syncthreads();
    if (kt + 1 < nkt) {
      kp += (size_t)64 * PW; vp += 64;
#pragma unroll
      for (int i = 0; i < 2; i++) rk[i] = *(const u32x4*)(kp + (size_t)(32 * i) * PW);
#pragma unroll
      for (int i = 0; i < 2; i++) rv[i] = *(const u32x4*)(vp + (size_t)(64 * i) * 2048);
    }
    if (kt * 64 <= qrow0 + 31) {
      f32x16 S[2];
#pragma unroll
      for (int a = 0; a < 2; a++)
#pragma unroll
        for (int i = 0; i < 16; i++) S[a][i] = 0.f;
#pragma unroll
      for (int kt2 = 0; kt2 < 2; kt2++)
#pragma unroll
        for (int s = 0; s < 4; s++) {
          bf16x8 a = *(const bf16x8*)(sK + (kt2 * 32 + l32) * 144 + s * 32 + hh * 16);
          S[kt2] = MFMA(a, Qf[s], S[kt2]);
        }
      if (kt * 64 + 63 > qrow0) {
#pragma unroll
        for (int kt2 = 0; kt2 < 2; kt2++)
#pragma unroll
          for (int i = 0; i < 16; i++) {
            const int key = kt * 64 + kt2 * 32 + crow(i, hh);
            if (key > qrow0 + l32) S[kt2][i] = -INFINITY;
          }
      }
      float mx = -INFINITY;
#pragma unroll
      for (int kt2 = 0; kt2 < 2; kt2++)
#pragma unroll
        for (int i = 0; i < 16; i++) mx = fmaxf(mx, S[kt2][i]);
      mx = fmaxf(mx, __shfl_xor(mx, 32));
      const float m_new = fmaxf(m_run, mx * sc);
      const float alpha = __builtin_amdgcn_exp2f(m_run - m_new);
      m_run = m_new;
      float ps = 0.f;
#pragma unroll
      for (int kt2 = 0; kt2 < 2; kt2++)
#pragma unroll
        for (int i = 0; i < 16; i++) {
          const float pv = __builtin_amdgcn_exp2f(S[kt2][i] * sc - m_new);
          S[kt2][i] = pv;
          ps += pv;
        }
      l_run = l_run * alpha + ps;
#pragma unroll
      for (int a = 0; a < 4; a++)
#pragma unroll
        for (int i = 0; i < 16; i++) O[a][i] *= alpha;
      bf16x8 Pf[4];
#pragma unroll
      for (int kk = 0; kk < 4; kk++) {
        const int kt2 = kk >> 1, s2 = kk & 1;
        u32x4 pk = {pk2(S[kt2][8 * s2 + 0], S[kt2][8 * s2 + 1]), pk2(S[kt2][8 * s2 + 2], S[kt2][8 * s2 + 3]),
                    pk2(S[kt2][8 * s2 + 4], S[kt2][8 * s2 + 5]), pk2(S[kt2][8 * s2 + 6], S[kt2][8 * s2 + 7])};
        Pf[kk] = __builtin_bit_cast(bf16x8, pk);
      }
#pragma unroll
      for (int dvt = 0; dvt < 4; dvt++)
#pragma unroll
        for (int kk = 0; kk < 4; kk++) {
          bf16x8 a = *(const bf16x8*)(sV + (dvt * 32 + l32) * 144 + kk * 32 + hh * 16);
          O[dvt] = MFMA(a, Pf[kk], O[dvt]);
        }
    }
  }
  const float ltot = l_run + __shfl_xor(l_run, 32);
  const float invl = 1.f / ltot;
  if (comp == 1) {
#pragma unroll
    for (int a = 0; a < 4; a++)
#pragma unroll
      for (int i = 0; i < 16; i++) sX[(wave * 64 + a * 16 + i) * 64 + lane] = O[a][i] * invl;
  }
  __syncthreads();
  if (comp == 0) {
    float ss = 0.f;
#pragma unroll
    for (int a = 0; a < 4; a++)
#pragma unroll
      for (int i = 0; i < 16; i++) {
        const float o = O[a][i] * invl - lam * sX[(wave * 64 + a * 16 + i) * 64 + lane];
        O[a][i] = o;
        ss += o * o;
      }
    ss += __shfl_xor(ss, 32);
    const float rs = rsqrtf(ss * (1.f / 128.f) + EPS) * (1.f - lam_init);
    const float* sg = p.in[19] + l * 128;
    u16* yp = ycat + (rowbase + qrow0 + l32) * YW + 512 + h * 128;
#pragma unroll
    for (int a = 0; a < 4; a++)
#pragma unroll
      for (int g4 = 0; g4 < 4; g4++) {
        const int dv = a * 32 + 8 * g4 + 4 * hh;
        const float4 gg = *(const float4*)(sg + dv);
        u32x2 v = {pk2(O[a][4 * g4] * rs * gg.x, O[a][4 * g4 + 1] * rs * gg.y),
                   pk2(O[a][4 * g4 + 2] * rs * gg.z, O[a][4 * g4 + 3] * rs * gg.w)};
        *(u32x2*)(yp + dv) = v;
      }
  }
}

template <class PT> DI void ssm_item(const PT& p, int l, int bl, int g, char* smem) {
  const u16* proj = (const u16*)(p.ws + O_PROJ);
  const u16* m2 = (const u16*)(p.ws + O_M2) + (size_t)(l * 24 + g) * 128 * 256;
  const u16* m13 = (const u16*)(p.ws + O_M13) + (size_t)(l * 24 + g) * 256 * 384;
  u16* yspre = (u16*)(p.ws + O_YSPRE);
  const int tid = opaque_tid() & 255, lane = tid & 63, wave = tid >> 6;
  const int l32 = lane & 31, hh = lane >> 5;
  const size_t rowbase = (size_t)bl * 2048;
  const u16* ua = proj + (rowbase + (size_t)(32 * wave + l32) * 16) * PW + C_U + g * 16 + hh * 8;
  __syncthreads();
  {
    f32x16 acc[4];
#pragma unroll
    for (int a = 0; a < 4; a++)
#pragma unroll
      for (int i = 0; i < 16; i++) acc[a][i] = 0.f;
#pragma unroll 4
    for (int s = 0; s < 16; s++) {
      bf16x8 a = *(const bf16x8*)(ua + (size_t)s * PW);
#pragma unroll
      for (int nt = 0; nt < 4; nt++) {
        bf16x8 b = *(const bf16x8*)(m2 + (size_t)(nt * 32 + l32) * 256 + s * 16 + hh * 8);
        acc[nt] = MFMA(a, b, acc[nt]);
      }
    }
#pragma unroll
    for (int nt = 0; nt < 4; nt++)
#pragma unroll
      for (int i = 0; i < 16; i++) {
        const int c = 32 * wave + crow(i, hh);
        *(float*)(smem + c * 528 + (nt * 32 + l32) * 4) = acc[nt][i];
      }
  }
  __syncthreads();
  if (wave == 0) {
    const float2 a16 = ((const float2*)(p.ws + O_A16))[(l * 24 + g) * 64 + lane];
    float sr = 0.f, si = 0.f;
    float nlr = *(volatile float*)(smem + lane * 4), nli = *(volatile float*)(smem + 256 + lane * 4);
    for (int c = 0; c < 128; c++) {
      const float lr = nlr, li = nli;
      if (c + 1 < 128) {
        nlr = *(volatile float*)(smem + (c + 1) * 528 + lane * 4);
        nli = *(volatile float*)(smem + (c + 1) * 528 + 256 + lane * 4);
      }
      asm volatile("" ::: "memory");
      *(volatile u16*)(smem + c * 528 + lane * 2) = f2bf(sr);
      *(volatile u16*)(smem + c * 528 + 128 + lane * 2) = f2bf(si);
      asm volatile("" ::: "memory");
      const float nr = a16.x * sr - a16.y * si + lr;
      const float ni = a16.x * si + a16.y * sr + li;
      sr = nr; si = ni;
    }
  }
  __syncthreads();
  const float* dsk = p.in[12] + l * 384 + g * 16;
#pragma unroll 1
  for (int half = 0; half < 2; half++) {
    f32x16 acc[4];
#pragma unroll
    for (int a = 0; a < 4; a++)
#pragma unroll
      for (int i = 0; i < 16; i++) acc[a][i] = 0.f;
#pragma unroll 4
    for (int s = 0; s < 16; s++) {
      bf16x8 a = *(const bf16x8*)(ua + (size_t)s * PW);
#pragma unroll
      for (int nt = 0; nt < 4; nt++) {
        if (s <= half * 8 + nt * 2 + 1) {
          bf16x8 b = *(const bf16x8*)(m13 + (size_t)(half * 128 + nt * 32 + l32) * 384 + s * 16 + hh * 8);
          acc[nt] = MFMA(a, b, acc[nt]);
        }
      }
    }
#pragma unroll 4
    for (int s = 0; s < 8; s++) {
      bf16x8 a = *(const bf16x8*)(smem + (32 * wave + l32) * 528 + s * 32 + hh * 16);
#pragma unroll
      for (int nt = 0; nt < 4; nt++) {
        bf16x8 b = *(const bf16x8*)(m13 + (size_t)(half * 128 + nt * 32 + l32) * 384 + 256 + s * 16 + hh * 8);
        acc[nt] = MFMA(a, b, acc[nt]);
      }
    }
#pragma unroll
    for (int nt = 0; nt < 4; nt++) {
      const int n = half * 128 + nt * 32 + l32;
      const int ti = n >> 4, hc = n & 15;
      const float dk = dsk[hc];
      u16 uv[16];
#pragma unroll
      for (int i = 0; i < 16; i++) {
        const int c = 32 * wave + crow(i, hh);
        const size_t tok = rowbase + (size_t)c * 16 + ti;
        uv[i] = proj[tok * PW + C_U + g * 16 + hc];
      }
      asm volatile("" ::: "memory");
#pragma unroll
      for (int i = 0; i < 16; i++) {
        const int c = 32 * wave + crow(i, hh);
        const size_t tok = rowbase + (size_t)c * 16 + ti;
        const float y = acc[nt][i] + dk * bf2f(uv[i]);
        yspre[tok * 384 + g * 16 + hc] = f2bf(gelu_tanh(y));
      }
    }
  }
}

template <class PT> DI void lru_item(const PT& p, int l, int bl, int tc, int hg, char* smem) {
  const u16* proj = (const u16*)(p.ws + O_PROJ);
  float* hloc = (float*)(p.ws + O_HLOC);
  float* pacc = (float*)(p.ws + O_PACC);
  const int tid0 = opaque_tid(), tid = tid0 & 255, lane = tid & 63, wave = tid >> 6;
  const int l32 = lane & 31, hh = lane >> 5;
  const int head = hg * 4 + wave, ch = head * 64 + lane;
  char* sXC = smem + (tid0 >> 6) * 13824;
  char* sGA = sXC + 4608;
  char* sGX = sXC + 9216;
  bf16x8 Wf[2][2][4];
#pragma unroll
  for (int mat = 0; mat < 2; mat++) {
    const float* wp = p.in[mat == 0 ? 22 : 24] + ((size_t)(l * 8 + head) * 64) * 64;
#pragma unroll
    for (int jt = 0; jt < 2; jt++)
#pragma unroll
      for (int s2 = 0; s2 < 4; s2++) {
        const float* q = wp + (size_t)(16 * s2 + 8 * hh) * 64 + jt * 32 + l32;
        u32x4 pk = {pk2(q[0], q[64]), pk2(q[128], q[192]), pk2(q[256], q[320]), pk2(q[384], q[448])};
        Wf[mat][jt][s2] = __builtin_bit_cast(bf16x8, pk);
      }
  }
  const float cw0 = p.in[20][(l * 4 + 0) * 512 + ch], cw1 = p.in[20][(l * 4 + 1) * 512 + ch];
  const float cw2 = p.in[20][(l * 4 + 2) * 512 + ch], cw3 = p.in[20][(l * 4 + 3) * 512 + ch];
  const float cb = p.in[21][l * 512 + ch], ba = p.in[23][l * 512 + ch], bx = p.in[25][l * 512 + ch];
  const float lamv = p.in[26][l * 512 + ch];
  const float sp = (lamv < 0.f) ? (-lamv + log1pf(expf(lamv))) : log1pf(expf(-lamv));
  const int t0 = tc * 64;
  const size_t rowbase = (size_t)bl * 2048;
  const u16* xp = proj + (rowbase + t0) * PW + C_XR + ch;
  float xm3 = 0.f, xm2 = 0.f, xm1 = 0.f;
  if (t0 > 0) {
    xm3 = bf2f(*(xp - (size_t)3 * PW));
    xm2 = bf2f(*(xp - (size_t)2 * PW));
    xm1 = bf2f(*(xp - (size_t)1 * PW));
  }
  float hl = 0.f, P = 1.f;
#pragma unroll 1
  for (int half = 0; half < 2; half++) {
    const float s3 = xm3, s2w = xm2, s1 = xm1;
    {
      float xv[32];
#pragma unroll
      for (int tt = 0; tt < 32; tt++) xv[tt] = bf2f(xp[(size_t)(half * 32 + tt) * PW]);
#pragma unroll
      for (int tt = 0; tt < 32; tt++) {
        const float x0 = xv[tt];
        const float xc = cw0 * xm3 + cw1 * xm2 + cw2 * xm1 + cw3 * x0 + cb;
        xm3 = xm2; xm2 = xm1; xm1 = x0;
        *(u16*)(sXC + tt * 144 + lane * 2) = f2bf(xc);
      }
    }
    asm volatile("s_waitcnt lgkmcnt(0)" ::: "memory");
#pragma unroll
    for (int mat = 0; mat < 2; mat++) {
      f32x16 acc[2];
#pragma unroll
      for (int jt = 0; jt < 2; jt++)
#pragma unroll
        for (int i = 0; i < 16; i++) acc[jt][i] = 0.f;
#pragma unroll
      for (int s2 = 0; s2 < 4; s2++) {
        const bf16x8 xb = *(const bf16x8*)(sXC + l32 * 144 + s2 * 32 + hh * 16);
#pragma unroll
        for (int jt = 0; jt < 2; jt++) acc[jt] = MFMA(Wf[mat][jt][s2], xb, acc[jt]);
      }
      char* sG = mat == 0 ? sGA : sGX;
#pragma unroll
      for (int jt = 0; jt < 2; jt++)
#pragma unroll
        for (int g4 = 0; g4 < 4; g4++) {
          const int jo = (jt * 32 + 8 * g4 + 4 * hh) * 2;
          u32x2 va = {pk2(acc[jt][4 * g4], acc[jt][4 * g4 + 1]), pk2(acc[jt][4 * g4 + 2], acc[jt][4 * g4 + 3])};
          *(u32x2*)(sG + l32 * 144 + jo) = va;
        }
      asm volatile("" ::: "memory");
    }
    asm volatile("s_waitcnt lgkmcnt(0)" ::: "memory");
    float xv2[32];
#pragma unroll
    for (int tt = 0; tt < 32; tt++) xv2[tt] = bf2f(xp[(size_t)(half * 32 + tt) * PW]);
    float y3 = s3, y2 = s2w, y1 = s1;
#pragma unroll
    for (int tt = 0; tt < 32; tt++) {
      const float ra = bf2f(*(const u16*)(sGA + tt * 144 + lane * 2)) + ba;
      const float rx = bf2f(*(const u16*)(sGX + tt * 144 + lane * 2)) + bx;
      const float xc = cw0 * y3 + cw1 * y2 + cw2 * y1 + cw3 * xv2[tt] + cb;
      y3 = y2; y2 = y1; y1 = xv2[tt];
      const float r = sigmoidf_(ra), ig = sigmoidf_(rx);
      const float log_a = -8.f * r * sp;
      const float a = __expf(log_a);
      const float bq = sqrtf(fmaxf(-expm1f(2.f * log_a), 0.f)) * (ig * xc);
      hl = a * hl + bq;
      P *= a;
      const size_t o = (rowbase + t0 + half * 32 + tt) * 512 + ch;
      hloc[o] = hl;
      pacc[o] = P;
    }
    asm volatile("s_waitcnt lgkmcnt(0)" ::: "memory");
  }
}

template <class PT> DI void phase_mixers(const PT& p, int l, unsigned* ctr, char* smem) {
  volatile int* s_item_p = (volatile int*)(smem + SMEM_BYTES - 64);
  constexpr int U_LRU = NB * 32, U_SSM = NB * 12;
  constexpr int U_ATT = NB * 4 * 16;
  constexpr int TOT = U_ATT + U_LRU + U_SSM;
  const int half = opaque_tid() >> 8;
  for (;;) {
    __syncthreads();
    if (threadIdx.x == 0) *s_item_p = (int)atomicAdd(ctr, 1u);
    __syncthreads();
    const int it = *s_item_p;
    if (it >= TOT) break;
    int kind, idx;
    if (it < U_SSM) { kind = 2; idx = it; }
    else if (it < U_SSM + 352) { kind = 0; idx = it - U_SSM; }
    else if (it < U_SSM + 352 + U_LRU) { kind = 1; idx = it - U_SSM - 352; }
    else { kind = 0; idx = it - U_SSM - U_LRU; }
    if (kind == 0) {
      const int qb = 15 - idx / (NB * 4), r = idx % (NB * 4);
      attn_item(p, l, r >> 2, r & 3, qb, smem);
    } else if (kind == 1) {
      const int j = idx * 2 + half;
      lru_item(p, l, j / 64, (j >> 1) & 31, j & 1, smem);
    } else {
      const int j = idx * 2 + half;
      ssm_item(p, l, j / 24, j % 24, smem + half * HALF_LDS);
    }
  }
}

template <class PT> DI void phase_lru2(const PT& p) {
  const u16* proj = (const u16*)(p.ws + O_PROJ);
  const float* hloc = (const float*)(p.ws + O_HLOC);
  const float* pacc = (const float*)(p.ws + O_PACC);
  u16* ycat = (u16*)(p.ws + O_YCAT);
  const int ch = opaque_tid();
  constexpr int NI = NB * 32;
  for (int it = blockIdx.x; it < NI; it += gridDim.x) {
    const int bl = it >> 5, tc = it & 31;
    const size_t rowbase = (size_t)bl * 2048;
    float hin = 0.f;
#pragma unroll 1
    for (int c0 = 0; c0 < tc; c0 += 8) {
      float pe[8], he[8];
#pragma unroll
      for (int k = 0; k < 8; k++) {
        const int c = (c0 + k < tc) ? (c0 + k) : (tc - 1);
        const size_t o = (rowbase + c * 64 + 63) * 512 + ch;
        pe[k] = pacc[o]; he[k] = hloc[o];
      }
#pragma unroll
      for (int k = 0; k < 8; k++) if (c0 + k < tc) hin = pe[k] * hin + he[k];
    }
#pragma unroll 1
    for (int t8 = 0; t8 < 64; t8 += 16) {
      float hl_[16], pa_[16]; u16 gr_[16];
#pragma unroll
      for (int k = 0; k < 16; k++) {
        const size_t row = rowbase + tc * 64 + t8 + k;
        hl_[k] = hloc[row * 512 + ch]; pa_[k] = pacc[row * 512 + ch]; gr_[k] = proj[row * PW + C_GR + ch];
      }
      asm volatile("" ::: "memory");
#pragma unroll
      for (int k = 0; k < 16; k++) {
        const size_t row = rowbase + tc * 64 + t8 + k;
        ycat[row * YW + 1024 + ch] = f2bf((hl_[k] + pa_[k] * hin) * gelu_tanh(bf2f(gr_[k])));
      }
    }
  }
  const int gt = blockIdx.x * 512 + ch, gs = gridDim.x * 512;
  for (int e = gt; e < TC * 16; e += gs) {
    const int r = e >> 4, cc = e & 15;
    unsigned zz = 0u; asm volatile("" : "+v"(zz)); u32x4 z = {zz, zz, zz, zz};
    *(u32x4*)(ycat + (size_t)r * YW + 384 + cc * 8) = z;
  }
}

template <class PT> DI void phase_xattn(const PT& p, char* smem) {
  const u16* qx = (const u16*)(p.ws + O_QX);
  const u16* kx = (const u16*)(p.ws + O_KX);
  const u16* vtx = (const u16*)(p.ws + O_VTX);
  u16* ox = (u16*)(p.ws + O_OX);
  const int tid0 = opaque_tid(), half = tid0 >> 8, tid = tid0 & 255, lane = tid & 63, wave = tid >> 6;
  const int l32 = lane & 31, hh = lane >> 5;
  char* hs = smem + half * HALF_LDS;
  constexpr int NI = (T / 128) * 4;
  const float sc = 0.0625f * 1.4426950408889634f;
  for (int it = opaque_bid() * 2 + half; it < NI; it += opaque_gdim() * 2) {
    const int head = it & 3, rb = it >> 2;
    const int r0 = rb * 128 + wave * 32;
    const int b = rb >> 4;
    f32x16 S[8];
#pragma unroll
    for (int a = 0; a < 8; a++)
#pragma unroll
      for (int i = 0; i < 16; i++) S[a][i] = 0.f;
#pragma unroll 1
    for (int dh = 0; dh < 2; dh++) {
      bf16x8 Qf[8];
      {
        const u16* qp = qx + (size_t)(r0 + l32) * 1024 + head * 256 + dh * 128 + hh * 8;
#pragma unroll
        for (int s = 0; s < 8; s++) Qf[s] = *(const bf16x8*)(qp + s * 16);
      }
#pragma unroll
      for (int ks = 0; ks < 4; ks++) {
        __syncthreads();
        {
          const u16* kb = kx + (size_t)(b * 256 + ks * 64 + (tid >> 4)) * 1024 + head * 256 + dh * 128 + (tid & 15) * 8;
          asm volatile("" : "+v"(kb));
#pragma unroll
          for (int i = 0; i < 4; i++)
            *(u32x4*)(hs + ((tid >> 4) + 16 * i) * 272 + (tid & 15) * 16) = *(const u32x4*)(kb + (size_t)(16 * i) * 1024);
        }
        __syncthreads();
#pragma unroll
        for (int kt2 = 0; kt2 < 2; kt2++)
#pragma unroll
          for (int s = 0; s < 8; s++) {
            bf16x8 a = *(const bf16x8*)(hs + (kt2 * 32 + l32) * 272 + s * 32 + hh * 16);
            S[ks * 2 + kt2] = MFMA(a, Qf[s], S[ks * 2 + kt2]);
          }
      }
    }
    float mx = -INFINITY;
#pragma unroll
    for (int a = 0; a < 8; a++)
#pragma unroll
      for (int i = 0; i < 16; i++) mx = fmaxf(mx, S[a][i]);
    mx = fmaxf(mx, __shfl_xor(mx, 32));
    const float mm = mx * sc;
    float ps = 0.f;
#pragma unroll
    for (int a = 0; a < 8; a++)
#pragma unroll
      for (int i = 0; i < 16; i++) {
        const float pv = __builtin_amdgcn_exp2f(S[a][i] * sc - mm);
        S[a][i] = pv;
        ps += pv;
      }
    ps += __shfl_xor(ps, 32);
    const float invl = 1.f / ps;
    bf16x8 Pf[16];
#pragma unroll
    for (int kk = 0; kk < 16; kk++) {
      const int a = kk >> 1, s2 = kk & 1;
      u32x4 pk = {pk2(S[a][8 * s2 + 0] * invl, S[a][8 * s2 + 1] * invl), pk2(S[a][8 * s2 + 2] * invl, S[a][8 * s2 + 3] * invl),
                  pk2(S[a][8 * s2 + 4] * invl, S[a][8 * s2 + 5] * invl), pk2(S[a][8 * s2 + 6] * invl, S[a][8 * s2 + 7] * invl)};
      Pf[kk] = __builtin_bit_cast(bf16x8, pk);
    }
#pragma unroll 1
    for (int dvt = 0; dvt < 8; dvt++) {
      __syncthreads();
      {
        const u16* vb = vtx + (size_t)(b * 1024 + head * 256 + dvt * 32 + (tid >> 5)) * 256 + (tid & 31) * 8;
        asm volatile("" : "+v"(vb));
#pragma unroll
        for (int i = 0; i < 4; i++)
          *(u32x4*)(hs + ((tid >> 5) + 8 * i) * 528 + (tid & 31) * 16) = *(const u32x4*)(vb + (size_t)(8 * i) * 256);
      }
      __syncthreads();
      f32x16 O;
#pragma unroll
      for (int i = 0; i < 16; i++) O[i] = 0.f;
#pragma unroll
      for (int kk = 0; kk < 16; kk++) {
        bf16x8 a = *(const bf16x8*)(hs + l32 * 528 + kk * 32 + hh * 16);
        O = MFMA(a, Pf[kk], O);
      }
      u16* op = ox + (size_t)(r0 + l32) * 1024 + head * 256 + dvt * 32;
#pragma unroll
      for (int g4 = 0; g4 < 4; g4++) {
        u32x2 v = {pk2(O[4 * g4], O[4 * g4 + 1]), pk2(O[4 * g4 + 2], O[4 * g4 + 3])};
        *(u32x2*)(op + 8 * g4 + 4 * hh) = v;
      }
    }
  }
}

template <class PT> DI void phase_ffn_act(const PT& p, int l) {
  const u16* up = (const u16*)(p.ws + O_UP);
  u16* act = (u16*)(p.ws + O_ACT);
  const float* cw = p.in[38] + (size_t)l * 3 * DUP;
  const float* cb = p.in[39] + (size_t)l * DUP;
  constexpr int CG = DFF / 8;
  constexpr int TB = 16;
  constexpr int NU = (TC / TB) * CG;
  const int tid = opaque_tid();
  for (int u = blockIdx.x * 512 + tid; u < NU; u += gridDim.x * 512) {
    const int tb = u / CG, cg = u - tb * CG;
    const int row0 = tb * TB;
    const int c0 = cg * 8;
    float wv[3][8], wg[3][8], bv[8], bgt[8];
#pragma unroll
    for (int j = 0; j < 3; j++) {
      const float4 a0 = *(const float4*)(cw + j * DUP + c0), a1 = *(const float4*)(cw + j * DUP + c0 + 4);
      const float4 b0 = *(const float4*)(cw + j * DUP + DFF + c0), b1 = *(const float4*)(cw + j * DUP + DFF + c0 + 4);
      wv[j][0] = a0.x; wv[j][1] = a0.y; wv[j][2] = a0.z; wv[j][3] = a0.w; wv[j][4] = a1.x; wv[j][5] = a1.y; wv[j][6] = a1.z; wv[j][7] = a1.w;
      wg[j][0] = b0.x; wg[j][1] = b0.y; wg[j][2] = b0.z; wg[j][3] = b0.w; wg[j][4] = b1.x; wg[j][5] = b1.y; wg[j][6] = b1.z; wg[j][7] = b1.w;
    }
    {
      const float4 a0 = *(const float4*)(cb + c0), a1 = *(const float4*)(cb + c0 + 4);
      const float4 b0 = *(const float4*)(cb + DFF + c0), b1 = *(const float4*)(cb + DFF + c0 + 4);
      bv[0] = a0.x; bv[1] = a0.y; bv[2] = a0.z; bv[3] = a0.w; bv[4] = a1.x; bv[5] = a1.y; bv[6] = a1.z; bv[7] = a1.w;
      bgt[0] = b0.x; bgt[1] = b0.y; bgt[2] = b0.z; bgt[3] = b0.w; bgt[4] = b1.x; bgt[5] = b1.y; bgt[6] = b1.z; bgt[7] = b1.w;
    }
    float v2[8], v1[8], g2[8], g1[8];
#pragma unroll
    for (int e = 0; e < 8; e++) { v2[e] = v1[e] = g2[e] = g1[e] = 0.f; }
    if ((row0 & 2047) != 0) {
      const u32x4 a2 = *(const u32x4*)(up + (size_t)(row0 - 2) * DUP + c0);
      const u32x4 a1 = *(const u32x4*)(up + (size_t)(row0 - 1) * DUP + c0);
      const u32x4 b2 = *(const u32x4*)(up + (size_t)(row0 - 2) * DUP + DFF + c0);
      const u32x4 b1 = *(const u32x4*)(up + (size_t)(row0 - 1) * DUP + DFF + c0);
#pragma unroll
      for (int e = 0; e < 4; e++) {
        v2[2 * e] = bflo(a2[e]); v2[2 * e + 1] = bfhi(a2[e]);
        v1[2 * e] = bflo(a1[e]); v1[2 * e + 1] = bfhi(a1[e]);
        g2[2 * e] = bflo(b2[e]); g2[2 * e + 1] = bfhi(b2[e]);
        g1[2 * e] = bflo(b1[e]); g1[2 * e + 1] = bfhi(b1[e]);
      }
    }
#pragma unroll 1
    for (int t8 = 0; t8 < TB; t8 += 8) {
      u32x4 ar[8], br[8];
#pragma unroll
      for (int k = 0; k < 8; k++) {
        ar[k] = *(const u32x4*)(up + (size_t)(row0 + t8 + k) * DUP + c0);
        br[k] = *(const u32x4*)(up + (size_t)(row0 + t8 + k) * DUP + DFF + c0);
      }
      asm volatile("" ::: "memory");
#pragma unroll
      for (int k = 0; k < 8; k++) {
        float v0[8], g0[8], o[8];
#pragma unroll
        for (int e = 0; e < 4; e++) {
          v0[2 * e] = bflo(ar[k][e]); v0[2 * e + 1] = bfhi(ar[k][e]);
          g0[2 * e] = bflo(br[k][e]); g0[2 * e + 1] = bfhi(br[k][e]);
        }
#pragma unroll
        for (int e = 0; e < 8; e++) {
          const float val = wv[0][e] * v2[e] + wv[1][e] * v1[e] + wv[2][e] * v0[e] + bv[e];
          const float gat = wg[0][e] * g2[e] + wg[1][e] * g1[e] + wg[2][e] * g0[e] + bgt[e];
          o[e] = gat * sigmoidf_(gat) * val;
          v2[e] = v1[e]; v1[e] = v0[e]; g2[e] = g1[e]; g1[e] = g0[e];
        }
        u32x4 ov = {pk2(o[0], o[1]), pk2(o[2], o[3]), pk2(o[4], o[5]), pk2(o[6], o[7])};
        *(u32x4*)(act + (size_t)(row0 + t8 + k) * DFF + c0) = ov;
      }
    }
  }
}

DI g8::Sched2 mk_sched(const void* A, const void* B, int M, int N, int lda, int ldb) {
  g8::Sched2 s;
  s.A0 = (const char*)A; s.B0 = (const char*)B; s.A1 = nullptr; s.B1 = nullptr;
  s.nM0 = M / 256; s.nN0 = N / 256; s.nM1 = 0; s.nN1 = 0;
  s.tsA = (size_t)256 * lda * 2; s.tsB = (size_t)256 * ldb * 2;
  s.G = gridDim.x; s.c = blockIdx.x;
  return s;
}

__global__ void __launch_bounds__(512) mega(Params p0) {
  extern __shared__ __attribute__((aligned(16))) char smem[];
  LAS unsigned char* lds = (LAS unsigned char*)smem;
  cg::grid_group grid = cg::this_grid();
  unsigned* bar = (unsigned*)(p0.ws + O_BAR);
  unsigned* ctrs = bar + 64;
  unsigned target = 0; (void)target;
  volatile unsigned* xst = (volatile unsigned*)(smem + SMEM_BYTES - 48);
  if (threadIdx.x == 0) { xst[0] = 0u; xst[1] = 0u; }
  __syncthreads();
  const XcdBarrier xbar = xcd_barrier_post((unsigned*)(p0.ws + O_XB), xst);
#ifdef PROBE_A
  unsigned ta = 0, tb = 0;
  unsigned tlast = (unsigned)__builtin_amdgcn_s_memrealtime();
#define TICK(k) do { const unsigned _n = (unsigned)__builtin_amdgcn_s_memrealtime(); if ((PROBE_A >> (k)) & 1) ta += _n - tlast; if ((PROBE_B >> (k)) & 1) tb += _n - tlast; tlast = _n; } while (0)
#else
#define TICK(k) do {} while (0)
#endif

  if (blockIdx.x == 0 && threadIdx.x == 0) {
    const float** tab = (const float**)(p0.ws + O_TAB);
#pragma unroll
    for (int i = 0; i < 42; i++) tab[i] = p0.in[i];
  }
  phase_init(p0);
  phase_ssm_setup(p0, smem);
  phase_convert_weights(p0, 0, smem);
  rmsnorm_rows(p0.in[1], p0.in[32], (u16*)(p0.ws + O_MEMN), MEMR);
  TICK(0);
  if (p0.ws == nullptr) grid.sync();
  xcd_barrier(xbar);
  TICK(11);
  Ctx p;
  p.in = (const float* const*)(p0.ws + O_TAB); p.ws = launder(p0.ws); p.out = launder(p0.out);

  for (int l = 0; l < DEPTH; l++) {
    const u16* wb = (const u16*)(p.ws + O_W);
    if (l > 0) {
      phase_convert_weights(p, l, smem);
      rmsnorm_rows(p.in[1], p.in[32] + l * 1024, (u16*)(p.ws + O_MEMN), MEMR);
      TICK(1);
      xcd_barrier(xbar); p.ws = launder(p0.ws); p.out = launder(p0.out);
      TICK(11);
    }
    rmsnorm_rows(l == 0 ? p.in[0] : p.out, p.in[3] + l * 1024, (u16*)(p.ws + O_HN), T);
    {
      g8::Sched2 s = mk_sched(p.ws + O_MEMN, wb + W_KV, MEMR, 1024, 1024, 1024);
      s.A1 = (const char*)(wb + W_KV + (size_t)1024 * 1024); s.B1 = p.ws + O_MEMN; s.nM1 = 4; s.nN1 = MEMR / 256;
      g8::EpiBf16 e{(u16*)(p.ws + O_KX), 1024, 1024, (u16*)(p.ws + O_VTX), 8, 1024};
      g8::gemm_phase<true>(lds, 1024, 1024, 1024, s, e);
    }
    TICK(2);
    xcd_barrier(xbar); p.ws = launder(p0.ws); p.out = launder(p0.out);
    TICK(11);
    {
      const int chunk = 0;
      const char* hnc = p.ws + O_HN;
      {
        g8::Sched2 s = mk_sched(hnc, wb + W_IN, TC, PWP, 1024, 1024);
        s.A1 = (const char*)(wb + W_V); s.B1 = hnc; s.nM1 = 2; s.nN1 = TC / 256;
        g8::EpiProj e{(u16*)(p.ws + O_PROJ), (const float2*)(p.ws + O_ROPE) + (size_t)chunk * TC * 32, (u16*)(p.ws + O_VT)};
        g8::gemm_phase<true>(lds, 1024, 1024, 1024, s, e);
      }
    }
    TICK(3);
    xcd_barrier(xbar); p.ws = launder(p0.ws); p.out = launder(p0.out);
    TICK(11);
    for (int chunk = 0; chunk < NCHUNK; chunk++) {
      float* x = p.out + (size_t)chunk * TC * 1024;
      phase_mixers(p, l, ctrs + l * NCHUNK + chunk, smem);
      TICK(4);
      xcd_barrier(xbar); p.ws = launder(p0.ws); p.out = launder(p0.out);
      TICK(11);
      {
        g8::Sched2 s = mk_sched(p.ws + O_YSPRE, wb + W_GLU, TC, 768, 384, 384);
        g8::EpiGlu e{(u16*)(p.ws + O_YCAT), p.in[14] + l * 768};
        g8::gemm_phase<true>(lds, 384, 384, 384, s, e);
      }
      phase_lru2(p);
      TICK(5);
      xcd_barrier(xbar); p.ws = launder(p0.ws); p.out = launder(p0.out);
      TICK(11);
      {
        g8::SchedMerge s;
        s.A = p.ws + O_YCAT; s.B = (const char*)(wb + W_BR); s.nM = TC / 256; s.nN = 4;
        s.tsA = (size_t)256 * YW * 2; s.tsB = (size_t)256 * YW * 2; s.G = gridDim.x; s.c = blockIdx.x;
        g8::EpiGateZ e{(const u16*)(p.ws + O_PROJ), (u16*)(p.ws + O_Z)};
        g8::gemm_phase<true>(lds, 512, YW, YW, s, e);
      }
      TICK(6);
      xcd_barrier(xbar); p.ws = launder(p0.ws); p.out = launder(p0.out);
      TICK(11);
      {
        g8::Sched2 s = mk_sched(p.ws + O_Z, wb + W_OUT, TC, 1024, 3072, 1024);
        g8::EpiResid e{x, l == 0 ? p.in[0] + (size_t)chunk * TC * 1024 : x};
        g8::gemm_phase<false, 16>(lds, 3072, 3072, 1024, s, e);
      }
      if (chunk + 1 < NCHUNK) {
        const int chunk_n = chunk + 1;
        const char* hnc = p.ws + O_HN + (size_t)chunk_n * TC * 1024 * 2;
        {
        g8::Sched2 s = mk_sched(hnc, wb + W_IN, TC, PWP, 1024, 1024);
        s.A1 = (const char*)(wb + W_V); s.B1 = hnc; s.nM1 = 2; s.nN1 = TC / 256;
        g8::EpiProj e{(u16*)(p.ws + O_PROJ), (const float2*)(p.ws + O_ROPE) + (size_t)chunk_n * TC * 32, (u16*)(p.ws + O_VT)};
        g8::gemm_phase<true>(lds, 1024, 1024, 1024, s, e);
        }
      }
      TICK(7);
      xcd_barrier(xbar); p.ws = launder(p0.ws); p.out = launder(p0.out);
      TICK(11);
    }
    rmsnorm_rows(p.out, p.in[31] + l * 1024, (u16*)(p.ws + O_HN), T);
    TICK(2);
    xcd_barrier(xbar); p.ws = launder(p0.ws); p.out = launder(p0.out);
    TICK(11);
    {
      g8::Sched2 s = mk_sched(p.ws + O_HN, wb + W_Q, T, 1024, 1024, 1024);
      g8::EpiBf16 e{(u16*)(p.ws + O_QX), 1024, 1024, nullptr, 0, 0};
      g8::gemm_phase<true>(lds, 1024, 1024, 1024, s, e);
    }
    TICK(8);
    xcd_barrier(xbar); p.ws = launder(p0.ws); p.out = launder(p0.out);
    TICK(11);
    phase_xattn(p, smem);
    TICK(9);
    xcd_barrier(xbar); p.ws = launder(p0.ws); p.out = launder(p0.out);
    TICK(11);
    {
      g8::Sched2 s = mk_sched(p.ws + O_OX, wb + W_O, T, 1024, 1024, 1024);
      g8::EpiResid e{p.out, p.out};
      g8::gemm_phase<false>(lds, 1024, 1024, 1024, s, e);
    }
    TICK(7);
    xcd_barrier(xbar); p.ws = launder(p0.ws); p.out = launder(p0.out);
    TICK(11);
    rmsnorm_rows(p.out, p.in[36] + l * 1024, (u16*)(p.ws + O_HN), T);
    TICK(2);
    xcd_barrier(xbar); p.ws = launder(p0.ws); p.out = launder(p0.out);
    TICK(11);
    {
      g8::Sched2 s = mk_sched(p.ws + O_HN, wb + W_UP, TC, DUP, 1024, 1024);
      g8::EpiBf16 e{(u16*)(p.ws + O_UP), DUP, DUP, nullptr, 0, 0};
      g8::gemm_phase<true>(lds, 1024, 1024, 1024, s, e);
    }
    TICK(8);
    xcd_barrier(xbar); p.ws = launder(p0.ws); p.out = launder(p0.out);
    TICK(11);
    for (int chunk = 0; chunk < NCHUNK; chunk++) {
      float* x = p.out + (size_t)chunk * TC * 1024;
      phase_ffn_act(p, l);
      TICK(10);
      xcd_barrier(xbar); p.ws = launder(p0.ws); p.out = launder(p0.out);
      TICK(11);
      {
        g8::Sched2 s = mk_sched(p.ws + O_ACT, wb + W_DOWN, TC, 1024, DFF, DFF);
        g8::EpiResid e{x, x};
        g8::gemm_phase<false>(lds, DFF, DFF, DFF, s, e);
      }
      if (chunk + 1 < NCHUNK) {
        const char* hnc = p.ws + O_HN + (size_t)(chunk + 1) * TC * 1024 * 2;
        g8::Sched2 s = mk_sched(hnc, wb + W_UP, TC, DUP, 1024, 1024);
        g8::EpiBf16 e{(u16*)(p.ws + O_UP), DUP, DUP, nullptr, 0, 0};
        g8::gemm_phase<true>(lds, 1024, 1024, 1024, s, e);
      }
      TICK(7);
      xcd_barrier(xbar); p.ws = launder(p0.ws); p.out = launder(p0.out);
      TICK(11);
    }
  }
#ifdef PROBE_A
  {
    unsigned* mw = (unsigned*)(p0.ws + O_BAR) + 128;
    if (blockIdx.x == 0 && threadIdx.x == 0) {
      __hip_atomic_store(mw, ta / 100u, __ATOMIC_RELAXED, __HIP_MEMORY_SCOPE_AGENT);
      const unsigned t0 = (unsigned)__builtin_amdgcn_s_memrealtime();
      while ((unsigned)__builtin_amdgcn_s_memrealtime() - t0 < tb) __builtin_amdgcn_s_sleep(8);
    }
    xcd_barrier(xbar);
    final_norm(p.out, p.in[41], __hip_atomic_load(mw, __ATOMIC_RELAXED, __HIP_MEMORY_SCOPE_AGENT));
  }
#else
  final_norm(p.out, p.in[41], 0u);
#endif
}

extern "C" void kernel_launch(void* const* d_in, const int* in_sizes, int n_in, void* d_out, int out_size,
                              void* d_ws, size_t ws_size, hipStream_t stream) {
  static int grid_blocks = 0;
  if (!grid_blocks) {
    int dev = 0, cus = 0, per_cu = 0;
    (void)hipGetDevice(&dev);
    (void)hipDeviceGetAttribute(&cus, hipDeviceAttributeMultiprocessorCount, dev);
    if (hipFuncSetAttribute((const void*)mega, hipFuncAttributeMaxDynamicSharedMemorySize, SMEM_BYTES) != hipSuccess)
      fprintf(stderr, "hipFuncSetAttribute failed\n");
    (void)hipOccupancyMaxActiveBlocksPerMultiprocessor(&per_cu, mega, 512, SMEM_BYTES);
    if (per_cu < 1) per_cu = 1;
    grid_blocks = cus;
    if (grid_blocks > NBLK) grid_blocks = NBLK;
  }
  if (ws_size < O_XB + 16384 || n_in < 42) {
    fprintf(stderr, "workspace too small: %zu < %zu\n", ws_size, (size_t)O_END);
    return;
  }
  Params p{};
  for (int i = 0; i < 42; i++) p.in[i] = (const float*)d_in[i];
  p.out = (float*)d_out;
  p.ws = (char*)d_ws;
  (void)hipMemsetAsync(d_ws, 0, 4096, stream);
  (void)hipMemsetAsync((char*)d_ws + O_XB, 0, 16384, stream);
  void* args[] = {&p};
  hipError_t e = hipLaunchCooperativeKernel((void*)mega, dim3(grid_blocks), dim3(512), args, SMEM_BYTES, stream);
  if (e != hipSuccess) fprintf(stderr, "cooperative launch failed: %s (grid %d)\n", hipGetErrorString(e), grid_blocks);
}
```
